# Optimizing an MI355X kernel written in HIP

```python
import math
import jax, jax.numpy as jnp
from jax import lax
import numpy as np

D_MODEL = 1024
BATCH = 16
SEQ = 2048
DEPTH = 2

SSD_HEADS = 16
SSD_HEAD_DIM = 64
SSD_WIDTH = SSD_HEADS * SSD_HEAD_DIM
SSD_GROUPS = 4
SSD_STATE = 128
CONV_K = 4
SSD_CHUNK = 128
CONV_DIM = SSD_WIDTH + 2 * SSD_GROUPS * SSD_STATE

ATT_HEADS = 16
ATT_HEAD_DIM = 64
ATT_WIDTH = ATT_HEADS * ATT_HEAD_DIM
ATT_BRANCHES = ((128, 1), (512, 4), (2048, 16))
BAND_BLOCK = 128

MIX_WIDTH = SSD_WIDTH + ATT_WIDTH
IN_PROJ = SSD_WIDTH + CONV_DIM + SSD_HEADS + 3 * ATT_WIDTH
D_FF = 2816
EPS = 1e-6

kernel_name = "hymba_ssd_dilated_macaron"


def rms_norm(x, w):
    xf = x.astype(jnp.float32)
    y = xf * lax.rsqrt(jnp.mean(xf * xf, axis=-1, keepdims=True) + EPS)
    return (y * w.astype(jnp.float32)).astype(x.dtype)


def swiglu(x, w_gate, w_up, w_down):
    return (jax.nn.silu(x @ w_gate) * (x @ w_up)) @ w_down


def causal_depthwise_conv(x, w, b):
    c = x.shape[-1]
    y = lax.conv_general_dilated(
        x, w[:, None, :], window_strides=(1,), padding=[(CONV_K - 1, 0)],
        dimension_numbers=("NWC", "WIO", "NWC"), feature_group_count=c)
    return y + b


def ssd_mixer(xbc, dt_raw, z, dt_bias, a_log, d_skip, norm_w):
    out_dtype = z.dtype
    b, s, _ = xbc.shape
    H, P, G, N, L = SSD_HEADS, SSD_HEAD_DIM, SSD_GROUPS, SSD_STATE, SSD_CHUNK
    R = H // G
    nc = s // L
    xbc = xbc.astype(jnp.float32)
    xs, bm, cm = jnp.split(xbc, [SSD_WIDTH, SSD_WIDTH + G * N], axis=-1)
    dt = jax.nn.softplus(dt_raw.astype(jnp.float32) + dt_bias.astype(jnp.float32))
    a = -jnp.exp(a_log.astype(jnp.float32))
    xh = xs.reshape(b, s, H, P)
    X = (xh * dt[..., None]).reshape(b, nc, L, G, R, P)
    adt = (dt * a).reshape(b, nc, L, G, R).transpose(0, 3, 4, 1, 2)
    a_cum = jnp.cumsum(adt, axis=-1)
    Bc = bm.reshape(b, nc, L, G, N)
    Cc = cm.reshape(b, nc, L, G, N)
    causal = jnp.tril(jnp.ones((L, L), dtype=bool))
    seg = a_cum[..., :, None] - a_cum[..., None, :]
    lmat = jnp.where(causal, jnp.exp(jnp.where(causal, seg, 0.0)), 0.0)
    cb = jnp.einsum("bclgn,bcsgn->bgcls", Cc, Bc)
    y_diag = jnp.einsum("bgcls,bgrcls,bcsgrp->bclgrp", cb, lmat, X)
    decay_states = jnp.exp(a_cum[..., -1:] - a_cum)
    states = jnp.einsum("bclgn,bgrcl,bclgrp->bcgrpn", Bc, decay_states, X)
    chunk_decay = jnp.exp(a_cum[..., -1])

    def step(h, inp):
        st, dec = inp
        return h * dec[..., None, None] + st, h

    h0 = jnp.zeros((b, G, R, P, N), jnp.float32)
    _, prev = lax.scan(step, h0, (states.transpose(1, 0, 2, 3, 4, 5),
                                  chunk_decay.transpose(3, 0, 1, 2)))
    y_off = jnp.einsum("bclgn,cbgrpn,bgrcl->bclgrp", Cc, prev, jnp.exp(a_cum))
    y = (y_diag + y_off).reshape(b, s, H, P) + xh * d_skip.astype(jnp.float32)[:, None]
    y = y.reshape(b, s, SSD_WIDTH) * jax.nn.silu(z.astype(jnp.float32))
    yg = y.reshape(b, s, G, SSD_WIDTH // G)
    yg = yg * lax.rsqrt(jnp.mean(yg * yg, axis=-1, keepdims=True) + EPS)
    y = yg.reshape(b, s, SSD_WIDTH) * norm_w.astype(jnp.float32)
    return y.astype(out_dtype)


def dilated_branch(q, k, v, dilation, back):
    b, s, h, e = q.shape
    n = s // dilation
    nb = -(-n // BAND_BLOCK)
    npad = nb * BAND_BLOCK
    blk = BAND_BLOCK

    def blocks(t):
        t = t.reshape(b, n, dilation, h, e)
        t = jnp.pad(t, ((0, 0), (0, npad - n), (0, 0), (0, 0), (0, 0)))
        return t.reshape(b, nb, blk, dilation, h, e)

    def with_prev(t):
        prev = jnp.pad(t[:, :-1], ((0, 0), (1, 0), (0, 0), (0, 0), (0, 0), (0, 0)))
        return jnp.concatenate([prev, t], axis=2)

    qb = blocks(q)
    kk = with_prev(blocks(k))
    vv = with_prev(blocks(v))
    scores = jnp.einsum("bnqrhe,bnkrhe->bnrhqk", qb, kk).astype(jnp.float32)
    scores = scores * (1.0 / math.sqrt(e))
    qi = jnp.arange(blk)[:, None]
    kj = jnp.arange(2 * blk)[None, :]
    dist = qi + blk - kj
    bidx = jnp.arange(nb)[:, None, None]
    valid = (dist >= 0) & (dist <= back) & (bidx * blk - blk + kj >= 0)
    scores = jnp.where(valid[None, :, None, None], scores, -jnp.inf)
    m = jnp.max(scores, axis=-1, keepdims=True)
    p = jnp.exp(scores - m)
    den = jnp.sum(p, axis=-1, keepdims=True)
    o = jnp.einsum("bnrhqk,bnkrhe->bnqrhe", (p / den).astype(v.dtype), vv)
    lse = (m + jnp.log(den))[..., 0]
    o = o.reshape(b, npad, dilation, h, e)[:, :n].reshape(b, s, h, e)
    lse = lse.transpose(0, 1, 4, 2, 3).reshape(b, npad, dilation, h)[:, :n].reshape(b, s, h)
    return o, lse


def dilated_attention(q, k, v):
    outs, lses = [], []
    for window, dilation in ATT_BRANCHES:
        o, lse = dilated_branch(q, k, v, dilation, window // dilation)
        outs.append(o)
        lses.append(lse)
    wts = jax.nn.softmax(jnp.stack(lses, axis=0), axis=0)
    y = jnp.einsum("kbsh,kbshe->bshe", wts.astype(q.dtype), jnp.stack(outs, axis=0))
    return y


def setup_inputs(seed: int = 0) -> dict:
    key = jax.random.key(seed)
    ks = jax.random.split(key, 24)
    f = jnp.float32

    def normal(k, shape, scale):
        return jax.random.normal(k, shape, f) * scale

    def gain(k, shape):
        return 1.0 + 0.02 * jax.random.normal(k, shape, f)

    dt = jnp.exp(jax.random.uniform(ks[10], (DEPTH, SSD_HEADS), f)
                 * (math.log(0.1) - math.log(0.001)) + math.log(0.001))
    return {
        "x": jax.random.normal(ks[0], (BATCH, SEQ, D_MODEL), f),
        "ffn1_norm": gain(ks[1], (DEPTH, D_MODEL)),
        "ffn1_w_gate": normal(ks[2], (DEPTH, D_MODEL, D_FF), D_MODEL ** -0.5),
        "ffn1_w_up": normal(ks[3], (DEPTH, D_MODEL, D_FF), D_MODEL ** -0.5),
        "ffn1_w_down": normal(ks[4], (DEPTH, D_FF, D_MODEL), D_FF ** -0.5),
        "mix_norm": gain(ks[5], (DEPTH, D_MODEL)),
        "w_in": normal(ks[6], (DEPTH, D_MODEL, IN_PROJ), D_MODEL ** -0.5),
        "conv_w": normal(ks[7], (DEPTH, CONV_K, CONV_DIM), CONV_K ** -0.5),
        "conv_b": normal(ks[8], (DEPTH, CONV_DIM), 0.02),
        "dt_bias": dt + jnp.log(-jnp.expm1(-dt)),
        "a_log": jnp.log(jax.random.uniform(ks[11], (DEPTH, SSD_HEADS), f, 1.0, 16.0)),
        "d_skip": gain(ks[12], (DEPTH, SSD_HEADS)),
        "ssd_norm": gain(ks[13], (DEPTH, SSD_WIDTH)),
        "q_norm": gain(ks[14], (DEPTH, ATT_HEAD_DIM)),
        "k_norm": gain(ks[15], (DEPTH, ATT_HEAD_DIM)),
        "w_out": normal(ks[16], (DEPTH, MIX_WIDTH, D_MODEL), MIX_WIDTH ** -0.5),
        "ffn2_norm": gain(ks[17], (DEPTH, D_MODEL)),
        "ffn2_w_gate": normal(ks[18], (DEPTH, D_MODEL, D_FF), D_MODEL ** -0.5),
        "ffn2_w_up": normal(ks[19], (DEPTH, D_MODEL, D_FF), D_MODEL ** -0.5),
        "ffn2_w_down": normal(ks[20], (DEPTH, D_FF, D_MODEL), D_FF ** -0.5),
    }


def reference(x, ffn1_norm, ffn1_w_gate, ffn1_w_up, ffn1_w_down, mix_norm, w_in,
              conv_w, conv_b, dt_bias, a_log, d_skip, ssd_norm, q_norm, k_norm,
              w_out, ffn2_norm, ffn2_w_gate, ffn2_w_up, ffn2_w_down):
    b, s, _ = x.shape
    splits = np.cumsum([SSD_WIDTH, CONV_DIM, SSD_HEADS, ATT_WIDTH, ATT_WIDTH]).tolist()
    for i in range(DEPTH):
        x = x + 0.5 * swiglu(rms_norm(x, ffn1_norm[i]), ffn1_w_gate[i], ffn1_w_up[i], ffn1_w_down[i])
        h = rms_norm(x, mix_norm[i])
        proj = h @ w_in[i]
        z, xbc, dt_raw, q, k, v = jnp.split(proj, splits, axis=-1)
        xbc = jax.nn.silu(causal_depthwise_conv(xbc, conv_w[i], conv_b[i]))
        y_ssd = ssd_mixer(xbc, dt_raw, z, dt_bias[i], a_log[i], d_skip[i], ssd_norm[i])
        q = rms_norm(q.reshape(b, s, ATT_HEADS, ATT_HEAD_DIM), q_norm[i])
        k = rms_norm(k.reshape(b, s, ATT_HEADS, ATT_HEAD_DIM), k_norm[i])
        v = v.reshape(b, s, ATT_HEADS, ATT_HEAD_DIM)
        y_att = dilated_attention(q, k, v).reshape(b, s, ATT_WIDTH)
        x = x + jnp.concatenate([y_ssd, y_att], axis=-1) @ w_out[i]
        x = x + 0.5 * swiglu(rms_norm(x, ffn2_norm[i]), ffn2_w_gate[i], ffn2_w_up[i], ffn2_w_down[i])
    return x
```

```cpp
#include <hip/hip_runtime.h>
#include <hip/hip_cooperative_groups.h>
#include <cstdio>
#include <cstdint>
namespace cg = cooperative_groups;
namespace pg8 {
#define PG8_LAS __attribute__((address_space(3)))
typedef unsigned short bf16_t;
typedef short bf16x8 __attribute__((ext_vector_type(8)));
typedef float f32x4 __attribute__((ext_vector_type(4)));
typedef unsigned u32x4 __attribute__((ext_vector_type(4)));
constexpr int BM = 256, BK = 64, HALF = 128, HTB = HALF * BK * 2  , STAGE_BYTES = 8 * HTB, NXCD = 8, WGM = 4;

__host__ __device__ __forceinline__ int lds_byte(int r, int c) { const int st = (r >> 4) * 2 + (c >> 5), rr = r & 15, cc = c & 31, ob = rr * 64 + cc * 2; return st * 1024 + (ob ^ (((ob >> 9) & 1) << 5)); }
__host__ __device__ __forceinline__ void stage_rc(int b, int& R, int& C) { const int st = b / 1024, sb = b % 1024, swz = sb ^ (((sb >> 9) & 1) << 5); R = (st >> 1) * 16 + swz / 64; C = (st & 1) * 32 + (swz % 64) / 2; }
__host__ __device__ __forceinline__ int perm32(int rho) { const int n = rho >> 4, i = rho & 15; return 8 * (i >> 2) + 4 * n + (i & 3); }

struct Unit { int pm, pn; };
struct Gemm { const bf16_t* A; const bf16_t* Bt; int M, N, K; };

struct StaticOrder {
    int nM, nN, nwg, G, c;
    __host__ __device__ void init(int M, int N, int G_, int c_) { nM = M / BM; nN = N / BM; nwg = nM * nN; G = G_; c = c_; }
    __host__ __device__ bool next(int i, Unit& u) const {
        const long L = (long)i * G + c; if (L >= nwg) return false;
        int wgid = (int)L; { const int q = nwg / NXCD, r = nwg % NXCD, xcd = wgid % NXCD, off = wgid / NXCD; wgid = (xcd < r ? xcd * (q + 1) : r * (q + 1) + (xcd - r) * q) + off; }
        const int nig = WGM * nN, gid = wgid / nig, fm = gid * WGM, gsz = (nM - fm) < WGM ? (nM - fm) : WGM;
        u.pm = fm + ((wgid % nig) % gsz); u.pn = (wgid % nig) / gsz; return true;
    }
    __device__ __forceinline__ void a_ready(const Unit&) const {}
    __device__ __forceinline__ void done(const Unit&) const {}
};

__device__ __forceinline__ unsigned cvt_pk_bf16(float lo, float hi) { unsigned r; asm volatile("v_cvt_pk_bf16_f32 %0, %1, %2" : "=v"(r) : "v"(lo), "v"(hi)); return r; }
typedef unsigned u32x2 __attribute__((ext_vector_type(2)));
__device__ __forceinline__ float row_rs(const float* ssq, int row) {
    const f32x4* p = (const f32x4*)(ssq + (size_t)row * 16);
    const f32x4 a = p[0], b = p[1], c = p[2], d = p[3];
    const float s = ((a[0] + a[1]) + (a[2] + a[3])) + ((b[0] + b[1]) + (b[2] + b[3])) + ((c[0] + c[1]) + (c[2] + c[3])) + ((d[0] + d[1]) + (d[2] + d[3]));
    return __builtin_amdgcn_rsqf(s * (1.0f / 1024.0f) + 1e-6f);
}
struct RsPrefetch {
    f32x4 p[4]; bool on;
    __device__ __forceinline__ void issue(const float* ssq, int pm, int wr, int wc, int fr, int fq, bool has) {
        const int wid = wr * 4 + wc, lane = fq * 16 + fr; on = has && lane < 32;
        if (on) { const f32x4* q = (const f32x4*)(ssq + (size_t)(pm * BM + 32 * wid + lane) * 16); p[0] = q[0]; p[1] = q[1]; p[2] = q[2]; p[3] = q[3]; }
    }
    __device__ __forceinline__ void commit(PG8_LAS float* tab, int wr, int wc, int fr, int fq) const {
        const int wid = wr * 4 + wc, lane = fq * 16 + fr;
        if (on) { const f32x4 c = (p[0] + p[1]) + (p[2] + p[3]); tab[32 * wid + lane] = __builtin_amdgcn_rsqf(((c[0] + c[1]) + (c[2] + c[3])) * (1.0f / 1024.0f) + 1e-6f); }
    }
};
__device__ __forceinline__ float silu_f(float x) { return x * __builtin_amdgcn_rcpf(1.0f + __builtin_amdgcn_exp2f(-1.4426950408889634f * x)); }

struct EpiSwiGLU {
    static constexpr bool PERM = true, AFTER_DRAIN = false;
    bf16_t* H; const float* ssq; int ldh; PG8_LAS float* rstab;
    __device__ __forceinline__ void operator()(const f32x4 (&acc)[2][2][4][2], const Unit& u, const Unit& un, bool has_next, int ui, int wr, int wc, int fr, int fq) const {
        const int row0 = u.pm * BM + wr * 64 + fr, col0 = u.pn * 128 + wc * 32 + 8 * fq;
        RsPrefetch rp; rp.issue(ssq, un.pm, wr, wc, fr, fq, has_next);
        const PG8_LAS float* rst = rstab + (ui & 1) * 256;
#pragma unroll
        for (int ai = 0; ai < 2; ++ai)
#pragma unroll
            for (int m = 0; m < 4; ++m) {
                const int row = row0 + ai * HALF + m * 16; const float rs = rst[ai * HALF + wr * 64 + m * 16 + fr];
                const float c1 = -1.4426950408889634f * rs, rs2 = rs * rs;
                const f32x4 G0 = acc[ai][0][m][0], G1 = acc[ai][0][m][1];
                f32x4 e0 = G0 * c1, e1 = G1 * c1;
#pragma unroll
                for (int j = 0; j < 4; ++j) { e0[j] = __builtin_amdgcn_exp2f(e0[j]); e1[j] = __builtin_amdgcn_exp2f(e1[j]); }
                e0 = e0 + 1.0f; e1 = e1 + 1.0f;
#pragma unroll
                for (int j = 0; j < 4; ++j) { e0[j] = __builtin_amdgcn_rcpf(e0[j]); e1[j] = __builtin_amdgcn_rcpf(e1[j]); }
                const f32x4 o0 = (G0 * acc[ai][1][m][0]) * (e0 * rs2), o1 = (G1 * acc[ai][1][m][1]) * (e1 * rs2);
                u32x4 w;
                w.x = cvt_pk_bf16(o0[0], o0[1]); w.y = cvt_pk_bf16(o0[2], o0[3]); w.z = cvt_pk_bf16(o1[0], o1[1]); w.w = cvt_pk_bf16(o1[2], o1[3]);
                __builtin_nontemporal_store(w, (u32x4*)(H + (size_t)row * ldh + col0));
                asm volatile("" ::: "memory");
            }
        rp.commit(rstab + ((ui + 1) & 1) * 256, wr, wc, fr, fq);
    }
    __device__ __forceinline__ void prime(const Unit& u, int wr, int wc, int fr, int fq) const { RsPrefetch rp; rp.issue(ssq, u.pm, wr, wc, fr, fq, true); rp.commit(rstab, wr, wc, fr, fq); }
};
struct EpiResid {
    static constexpr bool PERM = true, AFTER_DRAIN = false;
    bf16_t* XB; float* OUT; float* ssq; float alpha;
    __device__ __forceinline__ void operator()(const f32x4 (&acc)[2][2][4][2], const Unit& u, const Unit& un, bool has_next, int ui, int wr, int wc, int fr, int fq) const {
        const int row0 = u.pm * BM + wr * 64 + fr, col0 = u.pn * BM + wc * 64 + 8 * fq;
#pragma unroll
        for (int ai = 0; ai < 2; ++ai)
#pragma unroll
            for (int m = 0; m < 4; ++m) {
                const int row = row0 + ai * HALF + m * 16; float ss = 0.f;
#pragma unroll
                for (int bj = 0; bj < 2; ++bj) {
                    const size_t off = (size_t)row * 1024 + col0 + bj * 32;
                    const u32x4 r = *(const u32x4*)(XB + off);
                    f32x4 x0, x1;
                    x0[0] = __builtin_bit_cast(float, r.x << 16); x0[1] = __builtin_bit_cast(float, r.x & 0xffff0000u); x0[2] = __builtin_bit_cast(float, r.y << 16); x0[3] = __builtin_bit_cast(float, r.y & 0xffff0000u);
                    x1[0] = __builtin_bit_cast(float, r.z << 16); x1[1] = __builtin_bit_cast(float, r.z & 0xffff0000u); x1[2] = __builtin_bit_cast(float, r.w << 16); x1[3] = __builtin_bit_cast(float, r.w & 0xffff0000u);
                    x0 = x0 + acc[ai][bj][m][0] * alpha; x1 = x1 + acc[ai][bj][m][1] * alpha;
                    u32x4 w; w.x = cvt_pk_bf16(x0[0], x0[1]); w.y = cvt_pk_bf16(x0[2], x0[3]); w.z = cvt_pk_bf16(x1[0], x1[1]); w.w = cvt_pk_bf16(x1[2], x1[3]);
                    *(u32x4*)(XB + off) = w;
                    if (OUT) { *(f32x4*)(OUT + off) = x0; *(f32x4*)(OUT + off + 4) = x1; }
                    ss += ((x0[0] * x0[0] + x0[1] * x0[1]) + (x0[2] * x0[2] + x0[3] * x0[3])) + ((x1[0] * x1[0] + x1[1] * x1[1]) + (x1[2] * x1[2] + x1[3] * x1[3]));
                }
                ss += __shfl_xor(ss, 16); ss += __shfl_xor(ss, 32);
                if (fq == 0) ssq[(size_t)row * 16 + u.pn * 4 + wc] = ss;
                asm volatile("" ::: "memory");
            }
    }
    __device__ __forceinline__ void prime(const Unit&, int, int, int, int) const {}
};
struct EpiWin {
    static constexpr bool PERM = true, AFTER_DRAIN = false;
    bf16_t* ZQ; bf16_t* XBC; bf16_t* Kb; bf16_t* Vb; float* DT; const float* ssq; const float* qw; const float* kw; float qscale; PG8_LAS float* rstab;
    __device__ __forceinline__ void operator()(const f32x4 (&acc)[2][2][4][2], const Unit& u, const Unit& un, bool has_next, int ui, int wr, int wc, int fr, int fq) const {
        const int row0 = u.pm * BM + wr * 64 + fr; const int pn = u.pn;
        RsPrefetch rp; rp.issue(ssq, un.pm, wr, wc, fr, fq, has_next);
        const PG8_LAS float* rst = rstab + (ui & 1) * 256;
        if (pn < 12 || (pn >= 20 && pn < 24)) {
            bf16_t* base; int ld, colt;
            if (pn < 4) { base = ZQ; ld = 2048; colt = 256 * pn; } else if (pn < 12) { base = XBC; ld = 2048; colt = 256 * (pn - 4); } else { base = Vb; ld = 1024; colt = 256 * (pn - 20); }
            const int col0 = colt + wc * 64 + 8 * fq;
#pragma unroll
            for (int ai = 0; ai < 2; ++ai)
#pragma unroll
                for (int m = 0; m < 4; ++m) {
                    const int row = row0 + ai * HALF + m * 16; const float rs = rst[ai * HALF + wr * 64 + m * 16 + fr]; bf16_t* rowp = base + (size_t)row * ld + col0;
#pragma unroll
                    for (int bj = 0; bj < 2; ++bj) { const f32x4 v0 = acc[ai][bj][m][0] * rs, v1 = acc[ai][bj][m][1] * rs;
                        u32x4 w; w.x = cvt_pk_bf16(v0[0], v0[1]); w.y = cvt_pk_bf16(v0[2], v0[3]); w.z = cvt_pk_bf16(v1[0], v1[1]); w.w = cvt_pk_bf16(v1[2], v1[3]);
                        bf16_t* dstp = rowp + bj * 32;
                        if (pn >= 20) dstp = Vb + ((size_t)((row >> 11) * 16 + 4 * (pn - 20) + wc) * 2048 + (row & 2047)) * 64 + 32 * bj + 8 * fq;
                        __builtin_nontemporal_store(w, (u32x4*)dstp); }
                    asm volatile("" ::: "memory");
                }
        } else if (pn < 20) {
            const bool isq = pn < 16; const float* wgt = isq ? qw : kw; const float osc = isq ? qscale : 1.0f;
            bf16_t* base = isq ? ZQ : Kb; const int ld = isq ? 2048 : 1024; const int head = 4 * (pn - (isq ? 12 : 16)) + wc;
            const int col0 = (isq ? 1024 : 0) + head * 64 + 8 * fq;
            f32x4 wv[2][2];
#pragma unroll
            for (int bj = 0; bj < 2; ++bj)
#pragma unroll
                for (int n = 0; n < 2; ++n) wv[bj][n] = *(const f32x4*)(wgt + 32 * bj + 8 * fq + 4 * n) * osc;
#pragma unroll
            for (int ai = 0; ai < 2; ++ai)
#pragma unroll
                for (int m = 0; m < 4; ++m) {
                    const int row = row0 + ai * HALF + m * 16; const float rs = rst[ai * HALF + wr * 64 + m * 16 + fr];
                    bf16_t* rowp = isq ? base + (size_t)row * ld + col0 : Kb + ((size_t)((row >> 11) * 16 + head) * 2048 + (row & 2047)) * 64 + 8 * fq;
                    f32x4 v[2][2]; float ss = 0.f;
#pragma unroll
                    for (int bj = 0; bj < 2; ++bj)
#pragma unroll
                        for (int n = 0; n < 2; ++n) { v[bj][n] = acc[ai][bj][m][n] * rs; const f32x4 t = v[bj][n]; ss += (t[0] * t[0] + t[1] * t[1]) + (t[2] * t[2] + t[3] * t[3]); }
                    ss += __shfl_xor(ss, 16); ss += __shfl_xor(ss, 32);
                    const float rn = __builtin_amdgcn_rsqf(ss * (1.0f / 64.0f) + 1e-6f);
#pragma unroll
                    for (int bj = 0; bj < 2; ++bj) { const f32x4 v0 = v[bj][0] * wv[bj][0] * rn, v1 = v[bj][1] * wv[bj][1] * rn;
                        u32x4 w; w.x = cvt_pk_bf16(v0[0], v0[1]); w.y = cvt_pk_bf16(v0[2], v0[3]); w.z = cvt_pk_bf16(v1[0], v1[1]); w.w = cvt_pk_bf16(v1[2], v1[3]);
                        __builtin_nontemporal_store(w, (u32x4*)(rowp + bj * 32)); }
                    asm volatile("" ::: "memory");
                }
        } else {
            if (wc == 0 && fq < 2) {
#pragma unroll
                for (int ai = 0; ai < 2; ++ai)
#pragma unroll
                    for (int m = 0; m < 4; ++m) {
                        const int row = row0 + ai * HALF + m * 16; const float rs = rst[ai * HALF + wr * 64 + m * 16 + fr];
                        *(f32x4*)(DT + (size_t)row * 16 + 8 * fq) = acc[ai][0][m][0] * rs; *(f32x4*)(DT + (size_t)row * 16 + 8 * fq + 4) = acc[ai][0][m][1] * rs;
                        asm volatile("" ::: "memory");
                    }
            }
        }
        rp.commit(rstab + ((ui + 1) & 1) * 256, wr, wc, fr, fq);
    }
    __device__ __forceinline__ void prime(const Unit& u, int wr, int wc, int fr, int fq) const { RsPrefetch rp; rp.issue(ssq, u.pm, wr, wc, fr, fq, true); rp.commit(rstab, wr, wc, fr, fq); }
};
__device__ __forceinline__ void glds16_s(const void* sbase, unsigned voff, unsigned lds_dst) {
    asm volatile("s_mov_b32 m0, %2\n\ts_nop 0\n\tglobal_load_lds_dwordx4 %0, %1" : : "v"(voff), "s"(sbase), "s"(lds_dst) : "memory"); }
template <class Epi, class Sched, bool ALIGN_EPI = false, bool SP2 = false>
__device__ __forceinline__ void gemm_phase(PG8_LAS unsigned char* lds, const Gemm g, const Sched& S, const Epi& E) {
    int tid_l = threadIdx.x; asm volatile("" : "+v"(tid_l));
    const int tid = tid_l, wid = __builtin_amdgcn_readfirstlane(tid >> 6), lane = tid & 63, wr = wid >> 2, wc = wid & 3, fr = lane & 15, fq = lane >> 4;
    const int K = g.K, nt = K / BK;
    unsigned voffA[2], voffB[2];
#pragma unroll
    for (int i = 0; i < 2; ++i) { int R, C; stage_rc(tid * 16 + i * 8192, R, C); const int Rb = Epi::PERM ? ((R & ~31) + perm32(R & 31)) : R;
        voffA[i] = (unsigned)(R * K + C) * 2u; voffB[i] = (unsigned)(Rb * K + C) * 2u; }
    const size_t kstep = (size_t)(BK * 2);
    const size_t hstep = (size_t)HALF * K * 2;
    const size_t tstep = 2 * hstep;
    const unsigned ldsbase = (unsigned)(uintptr_t)lds;
    const unsigned ldsw = (unsigned)wid * 1024u;
    const int aoff = lds_byte(wr * 64 + fr, fq * 8), boff = lds_byte(wc * 32 + fr, fq * 8);
#define PG8_SA(b, h) (((b) * 2 + (h)) * HTB)
#define PG8_SB(b, h) ((4 + (b) * 2 + (h)) * HTB)
#define PG8_STAGE(bufoff, gbase, voff) do { _Pragma("unroll") for (int _i = 0; _i < 2; ++_i) \
        glds16_s((const void*)(gbase), (voff)[_i], ldsbase + (unsigned)(bufoff) + ldsw + _i * 8192u); } while (0)
#define PG8_LDA(dst, b, h) do { _Pragma("unroll") for (int m = 0; m < 4; ++m) _Pragma("unroll") for (int k = 0; k < 2; ++k) dst[m][k] = *(const PG8_LAS bf16x8*)(lds + PG8_SA(b, h) + aoff + m * 2048 + k * 1024); } while (0)
#define PG8_LDB(dst, b, h) do { _Pragma("unroll") for (int n = 0; n < 2; ++n) _Pragma("unroll") for (int k = 0; k < 2; ++k) dst[n][k] = *(const PG8_LAS bf16x8*)(lds + PG8_SB(b, h) + boff + n * 2048 + k * 1024); } while (0)
#define PG8_MMA(ai, bj, At, Bt) do { __builtin_amdgcn_s_setprio(1); _Pragma("unroll") for (int m = 0; m < 4; ++m) _Pragma("unroll") for (int n = 0; n < 2; ++n) _Pragma("unroll") for (int k = 0; k < 2; ++k) \
        acc[ai][bj][m][n] = __builtin_amdgcn_mfma_f32_16x16x32_bf16(Bt[n][k], At[m][k], acc[ai][bj][m][n], 0, 0, 0); __builtin_amdgcn_s_setprio(0); } while (0)
#define PG8_WAIT_V(n) asm volatile("s_waitcnt vmcnt(" #n ")" ::: "memory")
#define PG8_WAIT_L(n) asm volatile("s_waitcnt lgkmcnt(" #n ")" ::: "memory")
#define PG8_BAR __builtin_amdgcn_s_barrier()
#define PG8_SCHED __builtin_amdgcn_sched_barrier(0)
    Unit cur, nxt; int ui = 0;
    if (!S.next(0, cur)) return;
    f32x4 acc[2][2][4][2];
#pragma unroll
    for (int a = 0; a < 2; ++a)
#pragma unroll
        for (int b = 0; b < 2; ++b)
#pragma unroll
            for (int m = 0; m < 4; ++m)
#pragma unroll
                for (int n = 0; n < 2; ++n) acc[a][b][m][n] = (f32x4){0.f, 0.f, 0.f, 0.f};
    bf16x8 At[4][2], B0[2][2], B1[2][2];
    const char* cA = (const char*)g.A + (size_t)cur.pm * tstep; const char* cB = (const char*)g.Bt + (size_t)cur.pn * tstep;
    S.a_ready(cur);
    E.prime(cur, wr, wc, fr, fq);
    if constexpr (SP2) {
        PG8_STAGE(PG8_SB(0, 0), cB, voffB); PG8_STAGE(PG8_SB(0, 1), cB + hstep, voffB); PG8_STAGE(PG8_SA(0, 0), cA, voffA); PG8_STAGE(PG8_SA(0, 1), cA + hstep, voffA);
        if (wr == 1) PG8_BAR;
        PG8_WAIT_V(2); PG8_BAR;
        PG8_STAGE(PG8_SB(1, 0), cB + kstep, voffB); PG8_STAGE(PG8_SA(1, 0), cA + kstep, voffA); PG8_STAGE(PG8_SB(1, 1), cB + hstep + kstep, voffB);
        PG8_WAIT_V(6); PG8_BAR;
    } else {
        PG8_STAGE(PG8_SB(0, 0), cB, voffB); PG8_STAGE(PG8_SA(0, 0), cA, voffA); PG8_STAGE(PG8_SB(0, 1), cB + hstep, voffB); PG8_STAGE(PG8_SA(0, 1), cA + hstep, voffA);
        if (wr == 1) PG8_BAR;
        PG8_WAIT_V(4); PG8_BAR;
        PG8_STAGE(PG8_SB(1, 0), cB + kstep, voffB); PG8_STAGE(PG8_SA(1, 0), cA + kstep, voffA); PG8_STAGE(PG8_SB(1, 1), cB + hstep + kstep, voffB);
        PG8_WAIT_V(6); PG8_BAR;
    }
    for (;;) {
        const bool has_next = S.next(ui + 1, nxt);
        const char* nA = has_next ? (const char*)g.A + (size_t)nxt.pm * tstep : cA; const char* nB = has_next ? (const char*)g.Bt + (size_t)nxt.pn * tstep : cB;
        for (int t = 0; t < nt; t += 2) {
            const bool last = (t == nt - 2);
            const char* a1 = cA + (size_t)(t + 1) * kstep;
            const char* a2 = last ? nA : cA + (size_t)(t + 2) * kstep; const char* b2 = last ? nB : cB + (size_t)(t + 2) * kstep;
            const char* a3 = a2 + kstep; const char* b3 = b2 + kstep;
            if (last && has_next) S.a_ready(nxt);
            if constexpr (SP2) {
            PG8_LDB(B0, 0, 0); PG8_LDB(B1, 0, 1); PG8_SCHED; PG8_LDA(At, 0, 0); PG8_STAGE(PG8_SA(1, 1), a1 + hstep, voffA);
            PG8_WAIT_V(8); PG8_WAIT_L(0); PG8_BAR; PG8_MMA(0, 0, At, B0); PG8_MMA(0, 1, At, B1); PG8_BAR; PG8_SCHED;
            PG8_LDA(At, 0, 1); PG8_STAGE(PG8_SB(0, 0), b2, voffB); PG8_STAGE(PG8_SB(0, 1), b2 + hstep, voffB); PG8_STAGE(PG8_SA(0, 0), a2, voffA);
            PG8_WAIT_V(8); PG8_WAIT_L(0); PG8_BAR; PG8_MMA(1, 0, At, B0); PG8_MMA(1, 1, At, B1); PG8_BAR; PG8_SCHED;
            PG8_LDB(B0, 1, 0); PG8_LDB(B1, 1, 1); PG8_SCHED; PG8_LDA(At, 1, 0); PG8_STAGE(PG8_SA(0, 1), a2 + hstep, voffA);
            PG8_WAIT_V(8); PG8_WAIT_L(0); PG8_BAR; PG8_MMA(0, 0, At, B0); PG8_MMA(0, 1, At, B1); PG8_BAR; PG8_SCHED;
            PG8_LDA(At, 1, 1); PG8_STAGE(PG8_SB(1, 0), b3, voffB); PG8_STAGE(PG8_SB(1, 1), b3 + hstep, voffB); PG8_STAGE(PG8_SA(1, 0), a3, voffA);
            PG8_WAIT_V(8); PG8_WAIT_L(0); PG8_BAR; PG8_MMA(1, 0, At, B0); PG8_MMA(1, 1, At, B1); PG8_BAR; PG8_SCHED;
            } else {
            PG8_LDB(B0, 0, 0); PG8_SCHED; PG8_LDA(At, 0, 0); PG8_STAGE(PG8_SA(1, 1), a1 + hstep, voffA);
            PG8_WAIT_L(8); PG8_BAR; PG8_WAIT_L(0); PG8_MMA(0, 0, At, B0); PG8_BAR; PG8_SCHED;
            PG8_LDB(B1, 0, 1); PG8_STAGE(PG8_SB(0, 0), b2, voffB);
            PG8_BAR; PG8_WAIT_L(0); PG8_MMA(0, 1, At, B1); PG8_BAR;
            PG8_LDA(At, 0, 1); PG8_STAGE(PG8_SA(0, 0), a2, voffA);
            PG8_BAR; PG8_WAIT_L(0); PG8_MMA(1, 0, At, B0); PG8_BAR; PG8_SCHED;
            PG8_STAGE(PG8_SB(0, 1), b2 + hstep, voffB);
            PG8_WAIT_V(6); PG8_BAR; PG8_MMA(1, 1, At, B1); PG8_BAR;
            PG8_LDB(B0, 1, 0); PG8_SCHED; PG8_LDA(At, 1, 0); PG8_STAGE(PG8_SA(0, 1), a2 + hstep, voffA);
            PG8_WAIT_L(8); PG8_BAR; PG8_WAIT_L(0); PG8_MMA(0, 0, At, B0); PG8_BAR; PG8_SCHED;
            PG8_LDB(B1, 1, 1); PG8_STAGE(PG8_SB(1, 0), b3, voffB);
            PG8_BAR; PG8_WAIT_L(0); PG8_MMA(0, 1, At, B1); PG8_BAR;
            PG8_LDA(At, 1, 1); PG8_STAGE(PG8_SA(1, 0), a3, voffA);
            PG8_BAR; PG8_WAIT_L(0); PG8_MMA(1, 0, At, B0); PG8_BAR; PG8_SCHED;
            PG8_STAGE(PG8_SB(1, 1), b3 + hstep, voffB);
            PG8_WAIT_V(6); PG8_BAR; PG8_MMA(1, 1, At, B1); PG8_BAR;
            }
        }
        if constexpr (ALIGN_EPI) { if (wr == 0) PG8_BAR; }
        if constexpr (!Epi::AFTER_DRAIN) { E(acc, cur, nxt, has_next, ui, wr, wc, fr, fq); S.done(cur); }
        if (!has_next) break;
#pragma unroll
        for (int a = 0; a < 2; ++a)
#pragma unroll
            for (int b = 0; b < 2; ++b)
#pragma unroll
                for (int m = 0; m < 4; ++m)
#pragma unroll
                    for (int n = 0; n < 2; ++n) acc[a][b][m][n] = (f32x4){0.f, 0.f, 0.f, 0.f};
        cur = nxt; cA = nA; cB = nB; ++ui;
        if constexpr (ALIGN_EPI) { if (wr == 1) PG8_BAR; }
    }
    PG8_WAIT_V(0);
    if constexpr (!ALIGN_EPI) { if (wr == 0) PG8_BAR; }
    PG8_BAR;
    if constexpr (Epi::AFTER_DRAIN) { E.fused(acc, cur, wr, wc, fr, fq, lds, wid, lane); S.done(cur); }
#undef PG8_SA
#undef PG8_SB
#undef PG8_STAGE
#undef PG8_LDA
#undef PG8_LDB
#undef PG8_MMA
#undef PG8_WAIT_V
#undef PG8_WAIT_L
#undef PG8_BAR
#undef PG8_SCHED
}
}
#define LAS __attribute__((address_space(3)))
typedef unsigned short bf16_t;
typedef float f32x4 __attribute__((ext_vector_type(4)));
typedef float f32x2 __attribute__((ext_vector_type(2)));
typedef unsigned u32x4v __attribute__((ext_vector_type(4)));
typedef unsigned u32x2v __attribute__((ext_vector_type(2)));
constexpr int BATCH = 16, SEQ = 2048, DM = 1024, FF = 2816, NGU = 2 * FF, INPW = 6160, NIN = 6400, MIXW = 2048, CONVD = 2048;
constexpr int M = BATCH * SEQ;
constexpr int NPH = 17;
constexpr float C2 = 0.125f * 1.4426950408889634f;
constexpr size_t SZ_WGU = (size_t)NGU * DM * 2, SZ_WD = (size_t)DM * FF * 2, SZ_WIN = (size_t)NIN * DM * 2, SZ_WOUT = (size_t)DM * MIXW * 2;
constexpr size_t WS_WGU1 = 0, WS_WD1 = WS_WGU1 + SZ_WGU, WS_WIN = WS_WD1 + SZ_WD, WS_WOUT = WS_WIN + SZ_WIN, WS_WGU2 = WS_WOUT + SZ_WOUT, WS_WD2 = WS_WGU2 + SZ_WGU;
constexpr size_t WS_SSQ = WS_WD2 + SZ_WD, WS_DT = WS_SSQ + (size_t)M * 64, WS_SSDSS = WS_DT + (size_t)M * 64, WS_XB = WS_SSDSS + (size_t)M * 64;
constexpr size_t WS_BIG = WS_XB + (size_t)M * DM * 2;
constexpr size_t WS_ZQ = WS_BIG, WS_XBC = WS_ZQ + (size_t)M * 2048 * 2, WS_K = WS_XBC + (size_t)M * 2048 * 2, WS_V = WS_K + (size_t)M * 1024 * 2, WS_END = WS_V + (size_t)M * 1024 * 2;
constexpr size_t WS_HID = WS_BIG;
static_assert(WS_HID + (size_t)M * FF * 2 <= WS_K, "hid overlay");
constexpr size_t WS_CTL = WS_END, CTL_BYTES = 16384;
static_assert(WS_CTL + CTL_BYTES <= 536870912ull, "workspace");
constexpr int LDS_BYTES = 147456;

__device__ __forceinline__ unsigned f2bf(float f) { unsigned u = __builtin_bit_cast(unsigned, f); return (u + 0x7fffu + ((u >> 16) & 1u)) >> 16; }
typedef __bf16 bf16x2_t __attribute__((ext_vector_type(2)));
__device__ __forceinline__ unsigned pk2(float lo, float hi) { f32x2 v = {lo, hi}; bf16x2_t b = __builtin_convertvector(v, bf16x2_t); return __builtin_bit_cast(unsigned, b); }
__device__ __forceinline__ f32x4 bf4_to_f32(u32x2v r) { f32x4 o; o[0] = __builtin_bit_cast(float, r.x << 16); o[1] = __builtin_bit_cast(float, r.x & 0xffff0000u); o[2] = __builtin_bit_cast(float, r.y << 16); o[3] = __builtin_bit_cast(float, r.y & 0xffff0000u); return o; }
__device__ __forceinline__ float wave_sum(float v) {
#pragma unroll
    for (int o = 1; o < 64; o <<= 1) v += __shfl_xor(v, o);
    return v;
}
template <int CTRL> __device__ __forceinline__ float dpp_f(float v) { return __builtin_bit_cast(float, __builtin_amdgcn_update_dpp(0, __builtin_bit_cast(int, v), CTRL, 0xF, 0xF, true)); }
__device__ __forceinline__ float row16_sum(float y) { y += dpp_f<0xB1>(y); y += dpp_f<0x4E>(y); y += dpp_f<0x141>(y); y += dpp_f<0x140>(y); return y; }
__device__ __forceinline__ float sigmoid_f(float x) { return __builtin_amdgcn_rcpf(1.0f + __builtin_amdgcn_exp2f(-1.4426950408889634f * x)); }

enum { MAP_ID = 0, MAP_GU = 1, MAP_WIN = 2, MAP_RES = 3 };
__device__ __forceinline__ void conv_item(const float* W0, const float* W1, int K, int Nsrc, bf16_t* WT, int Ndst, const float* kscale, int kslim, int kind, LAS float* scr, int item, int lane) {
    const int nblk = Ndst / 32, kb = item / nblk, nb = item % nblk, k0 = 64 * kb;
    const float* W = W0; int src = 32 * nb, nv = 32;
    if (kind == MAP_GU) { const int pn = nb >> 3, bi = nb & 7; W = (bi >> 2) ? W1 : W0; src = 128 * pn + 32 * (bi & 3); }
    else if (kind == MAP_RES) { const int pn = nb >> 3, bi = nb & 7; src = 256 * pn + 64 * (bi & 3) + 32 * (bi >> 2); }
    else if (kind == MAP_WIN) { const int pn = nb >> 3, bi = nb & 7, bj = bi >> 2, wc = bi & 3;
        if (pn < 4) src = 256 * pn + 64 * wc + 32 * bj;
        else if (pn < 12) src = 1024 + 256 * (pn - 4) + 64 * wc + 32 * bj;
        else if (pn < 16) src = 3088 + 256 * (pn - 12) + 64 * wc + 32 * bj;
        else if (pn < 20) src = 4112 + 256 * (pn - 16) + 64 * wc + 32 * bj;
        else if (pn < 24) src = 5136 + 256 * (pn - 20) + 64 * wc + 32 * bj;
        else { src = 3072; nv = (bi == 0) ? 16 : 0; } }
    const int n4 = 4 * (lane & 7);
    f32x4 v[8];
#pragma unroll
    for (int i = 0; i < 8; ++i) { const int kk = 8 * i + (lane >> 3); v[i] = (f32x4){0.f, 0.f, 0.f, 0.f};
        if (n4 < nv) { v[i] = __builtin_nontemporal_load((const f32x4*)(W + (size_t)(k0 + kk) * Nsrc + src + n4)); if (kscale && (k0 + kk) < kslim) v[i] = v[i] * kscale[k0 + kk]; } }
#pragma unroll
    for (int i = 0; i < 8; ++i) { const int kk = 8 * i + (lane >> 3); *(LAS f32x4*)(scr + kk * 36 + n4) = v[i]; }
    asm volatile("s_waitcnt lgkmcnt(0)" ::: "memory");
    const int c = lane & 7;
#pragma unroll
    for (int j = 0; j < 4; ++j) { const int nn = (lane >> 3) + 8 * j; const LAS float* s = scr + (8 * c) * 36 + nn;
        u32x4v o; o.x = pk2(s[0 * 36], s[1 * 36]); o.y = pk2(s[2 * 36], s[3 * 36]); o.z = pk2(s[4 * 36], s[5 * 36]); o.w = pk2(s[6 * 36], s[7 * 36]);
        *(u32x4v*)(WT + (size_t)(32 * nb + nn) * K + k0 + 8 * c) = o; }
    asm volatile("s_waitcnt lgkmcnt(0)" ::: "memory");
}
struct Args { const float* in[20]; float* out; unsigned char* ws; int ph_lo, ph_hi; };
#define PTAB_OFF 146432
__device__ __forceinline__ const float* in_ptr(LAS unsigned char* lds, int i) { const LAS unsigned* p = (const LAS unsigned*)(lds + PTAB_OFF) + 2 * i; const unsigned lo = __builtin_amdgcn_readfirstlane(p[0]), hi = __builtin_amdgcn_readfirstlane(p[1]); return (const float*)(((unsigned long long)hi << 32) | lo); }
#define INP(i) in_ptr(lds, (i))
__device__ __forceinline__ void convert_weight(unsigned char* ws, int which, int L, LAS unsigned char* lds) {
    int tid_l = threadIdx.x; asm volatile("" : "+v"(tid_l));
    const int lane = tid_l & 63, wid = tid_l >> 6;
    LAS float* scr = (LAS float*)(lds + wid * 16384);
    const int gw = blockIdx.x * 8 + wid, NGW = gridDim.x * 8;
    const float* W0; const float* W1 = nullptr; int K, Nsrc, Ndst, kind, kslim = 1 << 30; const float* ks = nullptr; bf16_t* WT;
    if (which == 0 || which == 4) { const int o = which == 0 ? 0 : 15; W0 = INP(2 + o) + (size_t)L * DM * FF; W1 = INP(3 + o) + (size_t)L * DM * FF; ks = INP(1 + o) + L * DM;
        K = DM; Nsrc = FF; Ndst = NGU; kind = MAP_GU; WT = (bf16_t*)(ws + (which == 0 ? WS_WGU1 : WS_WGU2)); }
    else if (which == 1 || which == 5) { W0 = INP(which == 1 ? 4 : 19) + (size_t)L * FF * DM; K = FF; Nsrc = DM; Ndst = DM; kind = MAP_RES; WT = (bf16_t*)(ws + (which == 1 ? WS_WD1 : WS_WD2)); }
    else if (which == 2) { W0 = INP(6) + (size_t)L * DM * INPW; ks = INP(5) + L * DM; K = DM; Nsrc = INPW; Ndst = NIN; kind = MAP_WIN; WT = (bf16_t*)(ws + WS_WIN); }
    else { W0 = INP(15) + (size_t)L * MIXW * DM; ks = INP(12) + L * 1024; kslim = 1024; K = MIXW; Nsrc = DM; Ndst = DM; kind = MAP_RES; WT = (bf16_t*)(ws + WS_WOUT); }
    const int items = (K / 64) * (Ndst / 32);
    for (int it = gw; it < items; it += NGW) conv_item(W0, W1, K, Nsrc, WT, Ndst, ks, kslim, kind, scr, it, lane);
}

constexpr int ST = 32, NWIN = SEQ / ST;
constexpr int RSB = 272, RSX = 144, RSH = 272;
constexpr int IMG_B = 0, IMG_C = 32 * RSB, IMG_X = 2 * 32 * RSB, IMG_A = IMG_X + 32 * RSX, IMG_BYTES = IMG_A + 128;
constexpr int SSD_CW = 0, SSD_IMG = 6400, SSD_H = SSD_IMG + 2 * IMG_BYTES, SSD_XS = SSD_H + 2 * 64 * RSH, SSD_OUT = SSD_XS + 3 * ST * 64 * 4, SSD_END = SSD_OUT + 2 * ST * 64 * 4;
static_assert(SSD_END <= 131072 && (IMG_BYTES % 16) == 0 && (SSD_H % 16) == 0, "SSD LDS map");
constexpr float LOG2E = 1.4426950408889634f;
typedef short bf16x8_t __attribute__((ext_vector_type(8)));
typedef float f32x16 __attribute__((ext_vector_type(16)));
typedef short v4i16_t __attribute__((ext_vector_type(4)));
struct StageRegs { u32x2v rb[4]; u32x2v rx[5]; float dtr[2]; float dtt; };
__device__ __forceinline__ void ssd_stage_load(int wn, int tid, int b, int h, int g, const bf16_t* XBC, const bf16_t* XBA, const float* DT, StageRegs& R) {
    const int t0 = wn * ST, hl = tid - 256;
    { const int bq = tid & 63, seg = tid >> 6; const int ca = (bq < 32 ? 128 * g + 4 * bq : 512 + 128 * g + 4 * (bq - 32));
#pragma unroll
      for (int i = 0; i < 4; ++i) R.rb[i] = *(const u32x2v*)(XBA + ((size_t)(b * SEQ + t0 + 4 * seg + i)) * 1024 + ca); }
    if (hl >= 0) { const int xq = hl & 15, sp = hl >> 4; const int ch = h * 64 + 4 * xq; const int tf = t0 + 2 * sp - 3;
#pragma unroll
      for (int i = 0; i < 5; ++i) { const int tt = tf + i; R.rx[i] = *(const u32x2v*)(XBC + ((size_t)(b * SEQ + (tt < 0 ? 0 : tt))) * CONVD + ch); }
      R.dtr[0] = DT[((size_t)(b * SEQ + t0 + 2 * sp)) * 16 + h]; R.dtr[1] = DT[((size_t)(b * SEQ + t0 + 2 * sp + 1)) * 16 + h];
    }
    if ((tid >> 6) == 2) R.dtt = DT[((size_t)(b * SEQ + t0 + (tid & 31))) * 16 + h];
}
__device__ __forceinline__ f32x4 silu4(f32x4 a) { f32x4 o; o[0] = a[0] * sigmoid_f(a[0]); o[1] = a[1] * sigmoid_f(a[1]); o[2] = a[2] * sigmoid_f(a[2]); o[3] = a[3] * sigmoid_f(a[3]); return o; }
__device__ __forceinline__ float softplus_f(float v) {
    const float e = __builtin_amdgcn_exp2f(v * LOG2E); const float big = __builtin_amdgcn_logf(1.0f + e) * 0.6931471805599453f; const float sm = e * (1.0f - 0.5f * e);
    return v > 20.f ? v : (e < 1e-3f ? sm : big); }
__device__ __forceinline__ void ssd_stage_compute(int wn, int tid, LAS unsigned char* lds, const StageRegs& R, float dtb, float aneg) {
    LAS float* CW = (LAS float*)(lds + SSD_CW); LAS unsigned char* IMG = lds + SSD_IMG + (wn & 1) * IMG_BYTES; LAS float* XS = (LAS float*)(lds + SSD_XS) + (wn % 3) * (ST * 64);
    const int t0 = wn * ST, hl = tid - 256;
    { const int bq = tid & 63, seg = tid >> 6;
      LAS unsigned char* dst = IMG + (bq < 32 ? IMG_B + 8 * bq : IMG_C + 8 * (bq - 32)) + (4 * seg) * RSB;
#pragma unroll
      for (int j = 0; j < 4; ++j) *(LAS u32x2v*)(dst + j * RSB) = R.rb[j]; }
    if (hl >= 0) { const int xq = hl & 15, sp = hl >> 4; const int cwi = 4 * xq; const int tf = t0 + 2 * sp - 3;
      const f32x4 w0 = *(const LAS f32x4*)(CW + cwi), w1 = *(const LAS f32x4*)(CW + 320 + cwi), w2 = *(const LAS f32x4*)(CW + 640 + cwi), w3 = *(const LAS f32x4*)(CW + 960 + cwi), bs = *(const LAS f32x4*)(CW + 1280 + cwi);
      f32x4 x[5];
#pragma unroll
      for (int i = 0; i < 5; ++i) { x[i] = bf4_to_f32(R.rx[i]); if (tf + i < 0) x[i] = (f32x4){0.f, 0.f, 0.f, 0.f}; }
#pragma unroll
      for (int j = 0; j < 2; ++j) { const int s = 2 * sp + j; const f32x4 act = silu4(bs + w0 * x[j] + w1 * x[j + 1] + w2 * x[j + 2] + w3 * x[j + 3]);
          const float dtv = softplus_f(R.dtr[j] + dtb); const f32x4 xd = act * dtv;
          *(LAS f32x4*)(XS + s * 64 + 4 * xq) = act;
          u32x2v o; o.x = pk2(xd[0], xd[1]); o.y = pk2(xd[2], xd[3]); *(LAS u32x2v*)(IMG + IMG_X + s * RSX + 8 * xq) = o; }
    }
    if ((tid >> 6) == 2) {
        float x = softplus_f(R.dtt + dtb) * aneg;
        x += dpp_f<0x111>(x); x += dpp_f<0x112>(x); x += dpp_f<0x114>(x); x += dpp_f<0x118>(x);
        x += __builtin_bit_cast(float, __builtin_amdgcn_update_dpp(0, __builtin_bit_cast(int, x), 0x142, 0xA, 0xF, false));
        if ((tid & 63) < 32) ((LAS float*)(IMG + IMG_A))[tid & 63] = x;
    }
}
struct ZRegs { u32x2v z; };
__device__ __forceinline__ void ssd_loadz(int wz, int tid, int b, int h, const bf16_t* ZQ, ZRegs& Z) {
    const int s = tid >> 4, pq = tid & 15, t = wz * ST + s; Z.z = *(const u32x2v*)(ZQ + ((size_t)(b * SEQ + t)) * 2048 + h * 64 + 4 * pq);
}
template <bool DRY> __device__ __forceinline__ void ssd_post(int wp, int tid, int b, int h, LAS unsigned char* lds, bf16_t* ZQ, float* SSDSS, float Dh, const ZRegs& Z) {
    const LAS float* OUT = (const LAS float*)(lds + SSD_OUT) + (wp & 1) * (ST * 64); const LAS float* XS = (const LAS float*)(lds + SSD_XS) + (wp % 3) * (ST * 64);
    const int s = tid >> 4, pq = tid & 15, t = wp * ST + s;
    const f32x4 y = *(const LAS f32x4*)(OUT + s * 64 + 4 * pq) + *(const LAS f32x4*)(XS + s * 64 + 4 * pq) * Dh;
    bf16_t* zp = ZQ + ((size_t)(b * SEQ + t)) * 2048 + h * 64 + 4 * pq;
    const f32x4 z = bf4_to_f32(Z.z);
    f32x4 yg; yg[0] = y[0] * z[0] * sigmoid_f(z[0]); yg[1] = y[1] * z[1] * sigmoid_f(z[1]); yg[2] = y[2] * z[2] * sigmoid_f(z[2]); yg[3] = y[3] * z[3] * sigmoid_f(z[3]);
    float ss = (yg[0] * yg[0] + yg[1] * yg[1]) + (yg[2] * yg[2] + yg[3] * yg[3]);
    ss = row16_sum(ss);
    u32x2v w; w.x = pk2(yg[0], yg[1]); w.y = pk2(yg[2], yg[3]);
    if (!DRY) { *(u32x2v*)zp = w; if (pq == 0) SSDSS[((size_t)(b * SEQ + t)) * 16 + h] = ss; }
    else if (ss == 12345.678f) { *(u32x2v*)zp = w; }
}
__device__ __forceinline__ bf16x8_t tr_pair(const LAS unsigned char* p0, const LAS unsigned char* p1) {
    const v4i16_t lo = __builtin_amdgcn_ds_read_tr16_b64_v4i16((LAS v4i16_t*)p0), hh = __builtin_amdgcn_ds_read_tr16_b64_v4i16((LAS v4i16_t*)p1);
    return (bf16x8_t){lo[0], lo[1], lo[2], lo[3], hh[0], hh[1], hh[2], hh[3]};
}
__device__ __forceinline__ void ssd_prepass(int item, const bf16_t* XBC, bf16_t* XBA, const float* conv_w, const float* conv_b) {
    int tid = threadIdx.x; asm volatile("" : "+v"(tid));
    const int b = item >> 4, h = item & 15, g = h >> 2;
    const int gq = (h & 3) * 16 + (tid & 15), chunk = tid >> 4;
    const int ch = gq < 32 ? 1024 + 128 * g + 4 * gq : 1536 + 128 * g + 4 * (gq - 32);
    const f32x4 w0 = *(const f32x4*)(conv_w + ch), w1 = *(const f32x4*)(conv_w + CONVD + ch), w2 = *(const f32x4*)(conv_w + 2 * CONVD + ch), w3 = *(const f32x4*)(conv_w + 3 * CONVD + ch), bs = *(const f32x4*)(conv_b + ch);
    const bf16_t* src = XBC + ((size_t)(b * SEQ)) * CONVD + ch; bf16_t* dst = XBA + ((size_t)(b * SEQ)) * 1024 + (ch - 1024);
    const int tb = 64 * chunk;
    f32x4 x0, x1, x2;
    if (tb == 0) { x0 = (f32x4){0.f, 0.f, 0.f, 0.f}; x1 = x0; x2 = x0; }
    else { x0 = bf4_to_f32(*(const u32x2v*)(src + (size_t)(tb - 3) * CONVD)); x1 = bf4_to_f32(*(const u32x2v*)(src + (size_t)(tb - 2) * CONVD)); x2 = bf4_to_f32(*(const u32x2v*)(src + (size_t)(tb - 1) * CONVD)); }
    for (int j0 = 0; j0 < 64; j0 += 8) {
        u32x2v raw[8];
#pragma unroll
        for (int j = 0; j < 8; ++j) raw[j] = *(const u32x2v*)(src + (size_t)(tb + j0 + j) * CONVD);
#pragma unroll
        for (int j = 0; j < 8; ++j) { const f32x4 x3 = bf4_to_f32(raw[j]); const f32x4 a = silu4(bs + w0 * x0 + w1 * x1 + w2 * x2 + w3 * x3);
            u32x2v o; o.x = pk2(a[0], a[1]); o.y = pk2(a[2], a[3]); *(u32x2v*)(dst + (size_t)(tb + j0 + j) * 1024) = o; x0 = x1; x1 = x2; x2 = x3; }
    }
}
template <bool DRY> __device__ __forceinline__ void ssd_window(int w, int tid, int lane, int wid, int b, int h, int g, LAS unsigned char* lds, const bf16_t* XBC, const bf16_t* XBA, const float* DT, bf16_t* ZQ, float* SSDSS,
                                                              float dtb, float aneg, float Dh, f32x16& hacc0, f32x16& hacc1, StageRegs& R, ZRegs& Z) {
    const int c = lane & 31, hi = lane >> 5, q4 = (lane & 15) >> 2, p4 = lane & 3, g1 = (lane >> 4) & 1;
    const int pt = wid & 1, ntb = 2 * ((wid >> 1) & 1);
        if (wid < 4) {
            const LAS unsigned char* IMG = lds + SSD_IMG + (w & 1) * IMG_BYTES;
            const LAS unsigned char* Bi = IMG + IMG_B; const LAS unsigned char* Ci = IMG + IMG_C; const LAS unsigned char* Xi = IMG + IMG_X; const LAS float* AC = (const LAS float*)(IMG + IMG_A);
            const LAS unsigned char* Hc = lds + SSD_H + (w & 1) * (64 * RSH); LAS unsigned char* Hn = lds + SSD_H + ((w + 1) & 1) * (64 * RSH);
            const float aT = AC[31];
            if (wid < 2) {
                bf16x8_t cf[8];
#pragma unroll
                for (int kk = 0; kk < 8; ++kk) cf[kk] = *(const LAS bf16x8_t*)(Ci + c * RSB + (16 * kk + 8 * hi) * 2);
                f32x16 gq;
#pragma unroll
                for (int i = 0; i < 16; ++i) gq[i] = 0.f;
                f32x16 y;
#pragma unroll
                for (int i = 0; i < 16; ++i) y[i] = 0.f;
#pragma unroll
                for (int kk = 0; kk < 8; ++kk) {
                    const bf16x8_t bfr = *(const LAS bf16x8_t*)(Bi + c * RSB + (16 * kk + 8 * hi) * 2); const bf16x8_t hf = *(const LAS bf16x8_t*)(Hc + (32 * pt + c) * RSH + (16 * kk + 8 * hi) * 2);
                    gq = __builtin_amdgcn_mfma_f32_32x32x16_bf16(bfr, cf[kk], gq, 0, 0, 0); y = __builtin_amdgcn_mfma_f32_32x32x16_bf16(cf[kk], hf, y, 0, 0, 0); }
                const float at = AC[c];
                f32x4 as4[4];
#pragma unroll
                for (int rg = 0; rg < 4; ++rg) as4[rg] = *(const LAS f32x4*)(AC + 8 * rg + 4 * hi);
#pragma unroll
                for (int i = 0; i < 16; ++i) { const int s = (i & 3) + 8 * (i >> 2) + 4 * hi; const float e = __builtin_amdgcn_exp2f((at - as4[i >> 2][i & 3]) * LOG2E); gq[i] = (s <= c) ? gq[i] * e : 0.f; }
                bf16x8_t pf[2];
#pragma unroll
                for (int ks = 0; ks < 2; ++ks) { u32x4v wv; wv.x = pk2(gq[8 * ks + 0], gq[8 * ks + 1]); wv.y = pk2(gq[8 * ks + 2], gq[8 * ks + 3]); wv.z = pk2(gq[8 * ks + 4], gq[8 * ks + 5]); wv.w = pk2(gq[8 * ks + 6], gq[8 * ks + 7]); pf[ks] = __builtin_bit_cast(bf16x8_t, wv); }
#pragma unroll
                for (int i = 0; i < 16; ++i) y[i] *= __builtin_amdgcn_exp2f(as4[i >> 2][i & 3] * LOG2E);
#pragma unroll
                for (int ks = 0; ks < 2; ++ks) {
                    const LAS unsigned char* xa = Xi + (16 * ks + 4 * hi + q4) * RSX + (32 * pt + 16 * g1 + 4 * p4) * 2;
                    const bf16x8_t xf = tr_pair(xa, xa + 8 * RSX);
                    y = __builtin_amdgcn_mfma_f32_32x32x16_bf16(pf[ks], xf, y, 0, 0, 0);
                }
                LAS float* OUT = (LAS float*)(lds + SSD_OUT) + (w & 1) * (ST * 64);
#pragma unroll
                for (int i = 0; i < 16; ++i) OUT[((i & 3) + 8 * (i >> 2) + 4 * hi) * 64 + 32 * pt + c] = y[i];
            }
            const float decT = __builtin_amdgcn_exp2f(aT * LOG2E);
#pragma unroll
            for (int i = 0; i < 16; ++i) { hacc0[i] *= decT; hacc1[i] *= decT; }
            bf16x8_t xw[2];
#pragma unroll
            for (int ks = 0; ks < 2; ++ks) {
                const LAS unsigned char* xa = Xi + (16 * ks + 8 * hi + q4) * RSX + (32 * pt + 16 * g1 + 4 * p4) * 2;
                const bf16x8_t xr = tr_pair(xa, xa + 4 * RSX);
                const f32x4 a0 = *(const LAS f32x4*)(AC + 16 * ks + 8 * hi), a1 = *(const LAS f32x4*)(AC + 16 * ks + 8 * hi + 4);
                float f[8];
#pragma unroll
                for (int j = 0; j < 8; ++j) { const float xv = __builtin_bit_cast(float, ((unsigned)(unsigned short)xr[j]) << 16); const float aa = j < 4 ? a0[j & 3] : a1[j & 3]; f[j] = xv * __builtin_amdgcn_exp2f((aT - aa) * LOG2E); }
                u32x4v wv; wv.x = pk2(f[0], f[1]); wv.y = pk2(f[2], f[3]); wv.z = pk2(f[4], f[5]); wv.w = pk2(f[6], f[7]); xw[ks] = __builtin_bit_cast(bf16x8_t, wv);
            }
#pragma unroll
            for (int ks = 0; ks < 2; ++ks) {
                const LAS unsigned char* ba = Bi + (16 * ks + 8 * hi + q4) * RSB + (32 * ntb + 16 * g1 + 4 * p4) * 2;
                const bf16x8_t b0 = tr_pair(ba, ba + 4 * RSB), b1 = tr_pair(ba + 64, ba + 64 + 4 * RSB);
                hacc0 = __builtin_amdgcn_mfma_f32_32x32x16_bf16(b0, xw[ks], hacc0, 0, 0, 0);
                hacc1 = __builtin_amdgcn_mfma_f32_32x32x16_bf16(b1, xw[ks], hacc1, 0, 0, 0);
            }
#pragma unroll
            for (int rg = 0; rg < 4; ++rg) {
                u32x2v o0, o1; o0.x = pk2(hacc0[4 * rg], hacc0[4 * rg + 1]); o0.y = pk2(hacc0[4 * rg + 2], hacc0[4 * rg + 3]); o1.x = pk2(hacc1[4 * rg], hacc1[4 * rg + 1]); o1.y = pk2(hacc1[4 * rg + 2], hacc1[4 * rg + 3]);
                *(LAS u32x2v*)(Hn + (32 * pt + c) * RSH + (32 * ntb + 8 * rg + 4 * hi) * 2) = o0;
                *(LAS u32x2v*)(Hn + (32 * pt + c) * RSH + (32 * (ntb + 1) + 8 * rg + 4 * hi) * 2) = o1;
            }
        }
        if (w > 0) ssd_post<DRY>(w - 1, tid, b, h, lds, ZQ, SSDSS, Dh, Z);
        if (w + 1 < NWIN) ssd_stage_compute(w + 1, tid, lds, R, dtb, aneg);
        ssd_stage_load(w + 3 < NWIN ? w + 3 : NWIN - 1, tid, b, h, g, XBC, XBA, DT, R);
        ssd_loadz(w + 1 < NWIN ? w + 1 : NWIN - 1, tid, b, h, ZQ, Z);
        asm volatile("s_waitcnt lgkmcnt(0)" ::: "memory"); __builtin_amdgcn_s_barrier(); asm volatile("" ::: "memory");
}
template <bool DRY> __device__ __forceinline__ void ssd_item(LAS unsigned char* lds, int item, const bf16_t* XBC, const bf16_t* XBA, const float* DT, bf16_t* ZQ, float* SSDSS, const float* conv_w, const float* conv_b, const float* dt_bias, const float* a_log, const float* d_skip) {
    int tid_l = threadIdx.x; asm volatile("" : "+v"(tid_l));
    const int tid = tid_l, lane = tid & 63, wid = __builtin_amdgcn_readfirstlane(tid >> 6);
    const int b = item >> 4, h = item & 15, g = h >> 2;
    LAS float* CW = (LAS float*)(lds + SSD_CW);
    for (int i = tid; i < 1600; i += 512) { const int k = i / 320, c = i % 320; const int ch = c < 64 ? h * 64 + c : (c < 192 ? 1024 + 128 * g + (c - 64) : 1536 + 128 * g + (c - 192));
        CW[i] = k < 4 ? conv_w[k * CONVD + ch] : conv_b[ch]; }
    { unsigned zz = 0u; asm volatile("" : "+v"(zz));
      for (int i = tid; i < 64 * RSH / 16; i += 512) ((LAS u32x4v*)(lds + SSD_H))[i] = (u32x4v){zz, zz, zz, zz}; }
    const float dtb = dt_bias[h], aneg = -__expf(a_log[h]), Dh = d_skip[h];
    __syncthreads();
    StageRegs RA, RB; ZRegs ZA, ZB;
    ssd_stage_load(0, tid, b, h, g, XBC, XBA, DT, RA); ssd_stage_compute(0, tid, lds, RA, dtb, aneg);
    ssd_stage_load(1, tid, b, h, g, XBC, XBA, DT, RA); ssd_stage_load(2, tid, b, h, g, XBC, XBA, DT, RB); ssd_loadz(0, tid, b, h, ZQ, ZB);
    __syncthreads();
    f32x16 hacc0, hacc1;
#pragma unroll
    for (int i = 0; i < 16; ++i) { hacc0[i] = 0.f; hacc1[i] = 0.f; }
    for (int w = 0; w < NWIN; w += 2) {
        ssd_window<DRY>(w, tid, lane, wid, b, h, g, lds, XBC, XBA, DT, ZQ, SSDSS, dtb, aneg, Dh, hacc0, hacc1, RA, ZA);
        ssd_window<DRY>(w + 1, tid, lane, wid, b, h, g, lds, XBC, XBA, DT, ZQ, SSDSS, dtb, aneg, Dh, hacc0, hacc1, RB, ZB);
    }
    ssd_post<DRY>(NWIN - 1, tid, b, h, lds, ZQ, SSDSS, Dh, ZA);
    __syncthreads();
}

constexpr int ATT_EXL_OFF = 256 * 64 * 4, ATT_K_OFF = ATT_EXL_OFF + 1024, V_RS = 144, V_WAVE_BYTES = 32 * V_RS, ATT_V_OFF = ATT_K_OFF + 8 * V_WAVE_BYTES;
static_assert(ATT_V_OFF + 8 * V_WAVE_BYTES <= PTAB_OFF, "attention LDS");
__device__ __forceinline__ int ex_idx(int row, int ch) { return row * 64 + 4 * (ch ^ (row & 15)); }
__device__ __forceinline__ void attn_tile_desc(int br, int t, int wid, int J, int& kp0, int& kbase, bool& mask) {
    if (br == 0) { kp0 = 256 * J + 32 * wid - 128 + 32 * t; kbase = 32 * t; mask = (t == 0) || (t == 4); }
    else if (br == 1) { kp0 = 4 * (64 * J + 32 * (wid >> 2) - 128 + 32 * t) + (wid & 3); kbase = 32 * t; mask = (t == 0) || (t == 3); }
    else { kp0 = 16 * (32 * (t >> 1)) + 2 * wid + (t & 1); kbase = 32 * (t >> 1); mask = true; }
}
__device__ __forceinline__ void attn_load_V(const bf16_t* Vh, int kp0, int kstride, int vrow_l, int vch, u32x4v (&Vn)[4]) {
#pragma unroll
    for (int i = 0; i < 4; ++i) Vn[i] = *(const u32x4v*)(Vh + (size_t)(kp0 + kstride * (8 * i + vrow_l)) * 64 + 8 * vch);
}
#define CFENCE() asm volatile("" ::: "memory")
template <bool DRY> __device__ __forceinline__ void attn_unit(LAS unsigned char* lds, int b, int h, int J, bf16_t* ZQ, const bf16_t* Kb, const bf16_t* Vb, const float* SSDSS, float nbound, int tid_in) {
    int tid = tid_in; asm volatile("" : "+v"(tid));
    const int lane = tid & 63, wid = __builtin_amdgcn_readfirstlane(tid >> 6), c = lane & 31, hi = lane >> 5;
    LAS float* EX = (LAS float*)lds; LAS float* EXL = (LAS float*)(lds + ATT_EXL_OFF);
    LAS unsigned char* VL = lds + ATT_V_OFF + wid * V_WAVE_BYTES; LAS unsigned char* KL = lds + ATT_K_OFF + wid * V_WAVE_BYTES;
    const LAS unsigned char* kfr = KL + c * V_RS + 16 * hi;
    const size_t rowbase = (size_t)b * SEQ; const int P0 = 256 * J;
    const bf16_t* Kh = Kb + ((size_t)(b * 16 + h) * SEQ) * 64; const bf16_t* Vh = Vb + ((size_t)(b * 16 + h) * SEQ) * 64;
    const int vrow_l = lane >> 3, vch = lane & 7;
    LAS unsigned char* vtr = VL + (4 * hi + ((lane & 15) >> 2)) * V_RS + 32 * ((lane >> 4) & 1) + 8 * (lane & 3);
    if (!DRY) {
        u32x4v yv[4]; f32x4 sv[4];
#pragma unroll
        for (int i = 0; i < 4; ++i) { const size_t row = rowbase + P0 + (tid >> 3) + 64 * i; yv[i] = *(const u32x4v*)(ZQ + row * 2048 + h * 64 + 8 * (tid & 7)); sv[i] = *(const f32x4*)(SSDSS + row * 16 + 4 * (h >> 2)); }
#pragma unroll
        for (int i = 0; i < 4; ++i) { const size_t row = rowbase + P0 + (tid >> 3) + 64 * i; const float rr = __builtin_amdgcn_rsqf(((sv[i][0] + sv[i][1]) + (sv[i][2] + sv[i][3])) * (1.0f / 256.0f) + 1e-6f);
            const f32x4 lo = bf4_to_f32((u32x2v){yv[i].x, yv[i].y}) * rr, hi4 = bf4_to_f32((u32x2v){yv[i].z, yv[i].w}) * rr;
            u32x4v o; o.x = pk2(lo[0], lo[1]); o.y = pk2(lo[2], lo[3]); o.z = pk2(hi4[0], hi4[1]); o.w = pk2(hi4[2], hi4[3]); *(u32x4v*)(ZQ + row * 2048 + h * 64 + 8 * (tid & 7)) = o; }
    }
    for (int br = 0; br < 3; ++br) {
        int qpos, kstride, ntile, t0;
        if (br == 0) { qpos = P0 + 32 * wid + c; kstride = 1; ntile = 5; t0 = 4 - 8 * J - wid; }
        else if (br == 1) { qpos = 4 * (64 * J + 32 * (wid >> 2) + c) + (wid & 3); kstride = 4; ntile = 4; t0 = 4 - 2 * J - (wid >> 2); }
        else { qpos = 16 * (16 * J + (c & 15)) + 2 * wid + (c >> 4); kstride = 16; ntile = J >= 2 ? 2 * (((16 * J - 18) >> 5) + 1) : 0; t0 = 0; }
        if (t0 < 0) t0 = 0;
        const float w16 = br == 0 ? nbound + 1.5849625007f : (br == 1 ? nbound + 1.0f : nbound), w4 = br == 2 ? nbound : nbound + 1.0f;
        const int dlo = br == 0 ? 0 : 33; const unsigned dspan = br == 0 ? 128u : 95u;
        f32x16 o0, o1;
#pragma unroll
        for (int i = 0; i < 16; ++i) { o0[i] = 0.f; o1[i] = 0.f; }
        float lp = 0.f;
        if (t0 < ntile) {
        bf16x8_t qf[4];
        { const bf16_t* qp = ZQ + (rowbase + qpos) * 2048 + 1024 + h * 64 + 8 * hi;
#pragma unroll
          for (int d0 = 0; d0 < 4; ++d0) qf[d0] = *(const bf16x8_t*)(qp + 16 * d0); }
        u32x4v KA[4], KB[4], VA[4], VB[4];
        { int kp0, kbase; bool mk; attn_tile_desc(br, t0, wid, J, kp0, kbase, mk); attn_load_V(Kh, kp0, kstride, vrow_l, vch, KA); CFENCE(); attn_load_V(Vh, kp0, kstride, vrow_l, vch, VA); CFENCE();
          const bool v1 = t0 + 1 < ntile; attn_tile_desc(br, v1 ? t0 + 1 : t0, wid, J, kp0, kbase, mk); const int ks1 = v1 ? kstride : 0;
          attn_load_V(Kh, kp0, ks1, vrow_l, vch, KB); CFENCE(); attn_load_V(Vh, kp0, ks1, vrow_l, vch, VB); CFENCE(); }
#define ATT_STEP(KX, VX, tt) do { const int t = (tt); \
            int kp0, kbase; bool mk; attn_tile_desc(br, t, wid, J, kp0, kbase, mk); \
            const bool vn = t + 2 < ntile; int kpn, kbn; bool mkn; attn_tile_desc(br, vn ? t + 2 : t, wid, J, kpn, kbn, mkn); const int ksn = vn ? kstride : 0; \
            _Pragma("unroll") for (int i = 0; i < 4; ++i) *(LAS u32x4v*)(KL + (8 * i + vrow_l) * V_RS + 16 * vch) = KX[i]; \
            f32x16 s; \
            _Pragma("unroll") for (int i = 0; i < 16; ++i) { const bool q4 = ((c & 3) == (i & 3)); const bool q16 = q4 && (hi == ((c >> 2) & 1)) && (((c >> 3) & 1) == ((i >> 2) & 1)); s[i] = q16 ? w16 : (q4 ? w4 : nbound); }     \
            asm volatile("s_waitcnt lgkmcnt(0)" ::: "memory"); \
            _Pragma("unroll") for (int d0 = 0; d0 < 4; ++d0) { const bf16x8_t kf = *(const LAS bf16x8_t*)(kfr + 32 * d0); s = __builtin_amdgcn_mfma_f32_32x32x16_bf16(kf, qf[d0], s, 0, 0, 0); } \
            CFENCE(); attn_load_V(Kh, kpn, ksn, vrow_l, vch, KX); CFENCE(); \
            if (mk) { \
                int qv = c + 128; \
                if (br == 2) qv = ((c >> 4) == (t & 1)) ? 16 * J + (c & 15) : -(1 << 20); \
                const int dq = qv - kbase - 4 * hi; \
                _Pragma("unroll") for (int i = 0; i < 16; ++i) { const int diff = dq - ((i & 3) + 8 * (i >> 2)); const float e = __builtin_amdgcn_exp2f(s[i]); s[i] = ((unsigned)(diff - dlo) <= dspan) ? e : 0.f; } \
            } else { \
                _Pragma("unroll") for (int i = 0; i < 16; ++i) s[i] = __builtin_amdgcn_exp2f(s[i]); \
            } \
            float ls = 0.f; \
            _Pragma("unroll") for (int i = 0; i < 16; ++i) ls += s[i]; \
            lp += ls; \
            bf16x8_t pf[2]; \
            _Pragma("unroll") for (int ks = 0; ks < 2; ++ks) { u32x4v w; w.x = pk2(s[8 * ks + 0], s[8 * ks + 1]); w.y = pk2(s[8 * ks + 2], s[8 * ks + 3]); w.z = pk2(s[8 * ks + 4], s[8 * ks + 5]); w.w = pk2(s[8 * ks + 6], s[8 * ks + 7]); pf[ks] = __builtin_bit_cast(bf16x8_t, w); } \
            CFENCE(); \
            _Pragma("unroll") for (int i = 0; i < 4; ++i) *(LAS u32x4v*)(VL + (8 * i + vrow_l) * V_RS + 16 * vch) = VX[i]; \
            CFENCE(); attn_load_V(Vh, kpn, ksn, vrow_l, vch, VX); CFENCE(); \
            asm volatile("s_waitcnt lgkmcnt(0)" ::: "memory"); \
            _Pragma("unroll") for (int ks = 0; ks < 2; ++ks) { \
                _Pragma("unroll") for (int dt = 0; dt < 2; ++dt) { \
                    const v4i16_t lo = __builtin_amdgcn_ds_read_tr16_b64_v4i16((LAS v4i16_t*)(vtr + (16 * ks) * V_RS + 64 * dt)); \
                    const v4i16_t hh = __builtin_amdgcn_ds_read_tr16_b64_v4i16((LAS v4i16_t*)(vtr + (16 * ks + 8) * V_RS + 64 * dt)); \
                    const bf16x8_t vf = (bf16x8_t){lo[0], lo[1], lo[2], lo[3], hh[0], hh[1], hh[2], hh[3]}; \
                    if (dt == 0) o0 = __builtin_amdgcn_mfma_f32_32x32x16_bf16(vf, pf[ks], o0, 0, 0, 0); else o1 = __builtin_amdgcn_mfma_f32_32x32x16_bf16(vf, pf[ks], o1, 0, 0, 0); \
                } \
            } \
            asm volatile("s_waitcnt lgkmcnt(0)" ::: "memory"); \
        } while (0)
        for (int tl = t0; ; tl += 2) {
            ATT_STEP(KA, VA, tl);
            if (tl + 1 >= ntile) break;
            ATT_STEP(KB, VB, tl + 1);
            if (tl + 2 >= ntile) break;
        }
#undef ATT_STEP
        }
        lp += __shfl_xor(lp, 32);
        const int ql = qpos - P0;
#pragma unroll
        for (int rg = 0; rg < 4; ++rg) {
            LAS f32x4* e0 = (LAS f32x4*)(EX + ex_idx(ql, 2 * rg + hi)); LAS f32x4* e1 = (LAS f32x4*)(EX + ex_idx(ql, 8 + 2 * rg + hi));
            f32x4 a0 = (f32x4){o0[4 * rg], o0[4 * rg + 1], o0[4 * rg + 2], o0[4 * rg + 3]}, a1 = (f32x4){o1[4 * rg], o1[4 * rg + 1], o1[4 * rg + 2], o1[4 * rg + 3]};
            if (br > 0) { a0 += *e0; a1 += *e1; }
            *e0 = a0; *e1 = a1;
        }
        if (hi == 0) EXL[ql] = (br > 0 ? EXL[ql] : 0.f) + lp;
        asm volatile("s_waitcnt lgkmcnt(0)" ::: "memory"); __builtin_amdgcn_s_barrier(); asm volatile("" ::: "memory");
    }
    int tid2 = tid_in; asm volatile("" : "+v"(tid2));
    const int hrow = tid2 >> 1, hhalf = tid2 & 1;
    f32x4 home[8];
#pragma unroll
    for (int i = 0; i < 8; ++i) home[i] = *(const LAS f32x4*)(EX + ex_idx(hrow, 8 * hhalf + i));
    const float rl = 1.0f / EXL[hrow];
    bf16_t* op = ZQ + (rowbase + P0 + hrow) * 2048 + 1024 + h * 64 + 32 * hhalf;
#pragma unroll
    for (int i = 0; i < 4; ++i) { const f32x4 a = home[2 * i] * rl, bb = home[2 * i + 1] * rl; u32x4v w; w.x = pk2(a[0], a[1]); w.y = pk2(a[2], a[3]); w.z = pk2(bb[0], bb[1]); w.w = pk2(bb[2], bb[3]); if (!DRY || rl == 12345.678f) *(u32x4v*)(op + 8 * i) = w; }
    __syncthreads();
}
__device__ __forceinline__ void attn_phase(LAS unsigned char* lds, bf16_t* ZQ, const bf16_t* Kb, const bf16_t* Vb, const float* SSDSS, const float* qw, const float* kw) {
    int tid_l = threadIdx.x; asm volatile("" : "+v"(tid_l));
    const int lane = tid_l & 63;
    float mq = fabsf(qw[lane]), mk = fabsf(kw[lane]);
#pragma unroll
    for (int o = 1; o < 64; o <<= 1) { mq = fmaxf(mq, __shfl_xor(mq, o)); mk = fmaxf(mk, __shfl_xor(mk, o)); }
    const float nbound = -(64.0f * mq * mk * C2 * 1.01f);
    if (gridDim.x == 256) {
        const int blk = blockIdx.x, xcd = blk & 7, idx = blk >> 3, grp = xcd * 4 + (idx >> 3), k = idx & 7;
        for (int i = 0; i < 8; ++i) { const int bh = grp * 8 + i, J = (k + i) & 7;
#ifdef PROBE_ATT2
            attn_unit<true>(lds, bh >> 4, bh & 15, J, ZQ, Kb, Vb, SSDSS, nbound, tid_l);
#endif
            attn_unit<false>(lds, bh >> 4, bh & 15, J, ZQ, Kb, Vb, SSDSS, nbound, tid_l); }
    } else {
        for (int u = blockIdx.x; u < BATCH * 16 * 8; u += gridDim.x) attn_unit<false>(lds, (u >> 3) >> 4, (u >> 3) & 15, u & 7, ZQ, Kb, Vb, SSDSS, nbound, tid_l);
    }
}

#define XB_TMO      128
#define XB_XCNT(j)  (256  + 64 * (j))
#define XB_XSUB(j)  (1280 + 64 * (j))
#define XB_XGEN(j)  (2304 + 64 * (j))
#define XB_TOP      3328
#define XB_TOPGEN   3392
#define XCD_BAR_WORDS 3456
#define XB_SPIN_CAP (1u << 24)

__device__ __forceinline__ unsigned xb_ld(unsigned* p)              { return __hip_atomic_load(p, __ATOMIC_RELAXED, __HIP_MEMORY_SCOPE_AGENT); }
__device__ __forceinline__ unsigned xb_add(unsigned* p, unsigned v) { return __hip_atomic_fetch_add(p, v, __ATOMIC_RELAXED, __HIP_MEMORY_SCOPE_AGENT); }
__device__ __forceinline__ unsigned xb_xcc_id() { return (unsigned)__builtin_amdgcn_s_getreg((3 << 11) | 20) & 0xFu; }
#define XB_SPIN(cond, bar) do { unsigned _sp = 0; while (cond) { __builtin_amdgcn_s_sleep(1); \
    if ((++_sp & 255u) == 0u) { if (xb_ld(&(bar)[XB_TMO])) break; if (_sp > XB_SPIN_CAP) { atomicAdd(&(bar)[XB_TMO], 1u); break; } } } } while (0)

struct XcdBarrier {
    unsigned* bar; unsigned x;
    volatile LAS unsigned* st;
};

__device__ __forceinline__ XcdBarrier xcd_barrier_post(unsigned* bar, volatile LAS unsigned* st) {
    XcdBarrier b; b.bar = bar; b.x = xb_xcc_id(); b.st = st;
    if (threadIdx.x == 0) (void)xb_add(&bar[XB_XCNT(b.x)], 1u);
    return b;
}
__device__ __forceinline__ void xcd_barrier_complete(unsigned* bar, unsigned x, unsigned& nloc, unsigned& nx) {
    const unsigned G = gridDim.x * gridDim.y * gridDim.z;
    unsigned sum, cnt, mine, sp = 0u;
    for (;;) {
        sum = 0u; cnt = 0u; mine = 0u;
#pragma unroll
        for (unsigned j = 0; j < 16; ++j) { const unsigned c = xb_ld(&bar[XB_XCNT(j)]); sum += c; cnt += (c > 0u) ? 1u : 0u; mine = (j == x) ? c : mine; }
        if (sum == G) break;
        __builtin_amdgcn_s_sleep(1);
        if ((++sp & 255u) == 0u) { if (xb_ld(&bar[XB_TMO])) break; if (sp > XB_SPIN_CAP) { atomicAdd(&bar[XB_TMO], 1u); break; } }
    }
    nloc = mine > 0u ? mine : 1u; nx = cnt > 0u ? cnt : 1u;
}

__device__ __forceinline__ void xcd_barrier(const XcdBarrier& b) {
    asm volatile("s_waitcnt vmcnt(0)" ::: "memory");
    __syncthreads();
    if (threadIdx.x == 0) {
        unsigned* bar = b.bar;
        __builtin_amdgcn_s_waitcnt(0);
        unsigned nloc = b.st[0], nx = b.st[1];
        if (nloc == 0u) { xcd_barrier_complete(bar, b.x, nloc, nx); b.st[0] = nloc; b.st[1] = nx; }
        const unsigned old = xb_add(&bar[XB_XSUB(b.x)], 1u);
        const unsigned gen = old / nloc;
        if (old + 1u == (gen + 1u) * nloc) {
            __builtin_amdgcn_fence(__ATOMIC_RELEASE, "agent");
            asm volatile("s_waitcnt vmcnt(0)" ::: "memory");
            const unsigned og = xb_add(&bar[XB_TOP], 1u);
            const unsigned tg = og / nx;
            if (og + 1u == (tg + 1u) * nx) xb_add(&bar[XB_TOPGEN], 1u);
            else XB_SPIN(xb_ld(&bar[XB_TOPGEN]) == tg, bar);
            __builtin_amdgcn_fence(__ATOMIC_ACQUIRE, "agent");
            xb_add(&bar[XB_XGEN(b.x)], 1u);
            asm volatile("s_waitcnt vmcnt(0)" ::: "memory");
        } else {
            XB_SPIN(xb_ld(&bar[XB_XGEN(b.x)]) == gen, bar);
            __builtin_amdgcn_fence(__ATOMIC_ACQUIRE, "agent");
            asm volatile("s_waitcnt vmcnt(0)" ::: "memory");
        }
    }
    __syncthreads();
}

__device__ __forceinline__ void dt_pass(const bf16_t* XB, const bf16_t* WdtT, const float* SSQ, float* DT) {
    int lane = threadIdx.x & 63; asm volatile("" : "+v"(lane));
    const int wave_s = __builtin_amdgcn_readfirstlane(threadIdx.x >> 6);
    const int r16 = lane & 15, kg = lane >> 4;
    for (int rb = blockIdx.x * 8 + wave_s; rb < M / 16; rb += gridDim.x * 8) {
        const bf16_t* ap = XB + (size_t)(16 * rb + r16) * 1024 + 8 * kg; const bf16_t* bp = WdtT + (size_t)r16 * 1024 + 8 * kg;
        f32x4 acc = (f32x4){0.f, 0.f, 0.f, 0.f};
#pragma unroll 8
        for (int ks = 0; ks < 32; ++ks) { const bf16x8_t a = *(const bf16x8_t*)(ap + 32 * ks), b = *(const bf16x8_t*)(bp + 32 * ks); acc = __builtin_amdgcn_mfma_f32_16x16x32_bf16(a, b, acc, 0, 0, 0); }
#pragma unroll
        for (int rg = 0; rg < 4; ++rg) { const int row = 16 * rb + 4 * kg + rg; DT[(size_t)row * 16 + r16] = acc[rg] * pg8::row_rs(SSQ, row); }
    }
}

__global__ void __launch_bounds__(512, 2) hymba_fwd(Args a) {
    extern __shared__ __attribute__((aligned(16))) unsigned char lds_raw[];
    LAS unsigned char* lds = (LAS unsigned char*)lds_raw;
    cg::grid_group grid = cg::this_grid();
    const int G = gridDim.x;
    unsigned char* ws = a.ws;
    float* X = a.out;
    if (threadIdx.x == 0) {
#pragma unroll
        for (int i = 0; i < 20; ++i) { const unsigned long long p = (unsigned long long)a.in[i]; LAS unsigned* pt = (LAS unsigned*)(lds + PTAB_OFF) + 2 * i; pt[0] = (unsigned)p; pt[1] = (unsigned)(p >> 32); }
    }
    if (threadIdx.x < 2) ((LAS unsigned*)(lds + PTAB_OFF + 512))[threadIdx.x] = 0u;
    const int ph_lo = a.ph_lo, ph_hi = a.ph_hi;
    __syncthreads();
    const XcdBarrier xbar = xcd_barrier_post((unsigned*)(ws + WS_CTL), (volatile LAS unsigned*)(lds + PTAB_OFF + 512));
    bf16_t* XB = (bf16_t*)(ws + WS_XB); bf16_t* HID = (bf16_t*)(ws + WS_HID); bf16_t* ZQ = (bf16_t*)(ws + WS_ZQ); bf16_t* XBC = (bf16_t*)(ws + WS_XBC);
    bf16_t* Kb = (bf16_t*)(ws + WS_K); bf16_t* Vb = (bf16_t*)(ws + WS_V);
    float* SSQ = (float*)(ws + WS_SSQ); float* DT = (float*)(ws + WS_DT); float* SSDSS = (float*)(ws + WS_SSDSS);
    for (int ph = ph_lo; ph < ph_hi; ++ph) {
        if (ph > ph_lo) { if (ph == ph_lo + 1) grid.sync(); else xcd_barrier(xbar); }
#ifdef PROBE_BAR2
        if (ph > ph_lo + 1) { xcd_barrier(xbar); xcd_barrier(xbar); xcd_barrier(xbar); xcd_barrier(xbar); }
#endif
        int tid = threadIdx.x; asm volatile("" : "+v"(tid));
        const int lane = tid & 63, wid = tid >> 6;
        if (ph == 0) {
#ifdef PROBE_CONV2
            for (int rep = 0; rep < 2; ++rep)
#endif
            for (int w = 0; w < 6; ++w) convert_weight(ws, w, 0, lds);
            const int gw = blockIdx.x * 8 + wid, NGW = G * 8;
#ifdef PROBE_CONV2
            for (int rep = 0; rep < 2; ++rep)
#endif
            for (int m = gw; m < M; m += NGW) {
                const f32x4* xr = (const f32x4*)(INP(0) + (size_t)m * DM) + lane; u32x2v* xb = (u32x2v*)(XB + (size_t)m * DM) + lane;
                float s = 0.f;
#pragma unroll
                for (int j = 0; j < 4; ++j) { const f32x4 v = __builtin_nontemporal_load(xr + 64 * j); s += (v[0] * v[0] + v[1] * v[1]) + (v[2] * v[2] + v[3] * v[3]); u32x2v w; w.x = pk2(v[0], v[1]); w.y = pk2(v[2], v[3]); xb[64 * j] = w; }
                s = wave_sum(s);
                if (lane < 16) SSQ[(size_t)m * 16 + lane] = lane == 0 ? s : 0.f;
            }
            continue;
        }
        const int L = (ph - 1) >> 3, sub = (ph - 1) & 7;
        { int cv = -1;
          if (L == 0) { cv = sub == 1 ? 0 : sub == 2 ? 1 : sub == 3 ? 2 : sub == 6 ? 3 : sub == 7 ? 4 : -1; } else if (sub == 0) cv = 5;
#ifdef PROBE_CONV2
          if (cv >= 0) { convert_weight(ws, cv, 1, lds); __syncthreads(); }
#endif
          if (cv >= 0) { convert_weight(ws, cv, 1, lds); __syncthreads(); } }
        if (sub == 0 || sub == 6) {
            pg8::Gemm g{XB, (const bf16_t*)(ws + (sub == 0 ? WS_WGU1 : WS_WGU2)), M, NGU, DM}; pg8::StaticOrder S; S.init(M, NGU, G, (int)blockIdx.x);
            pg8::EpiSwiGLU E{HID, SSQ, FF, (LAS float*)(lds + 132096)};
#ifdef PROBE_GEMM2
            pg8::gemm_phase<pg8::EpiSwiGLU, pg8::StaticOrder, true, true>(lds, g, S, E); __syncthreads();
#endif
            pg8::gemm_phase<pg8::EpiSwiGLU, pg8::StaticOrder, true, true>(lds, g, S, E);
        } else if (sub == 1 || sub == 7 || sub == 5) {
            pg8::Gemm g{sub == 5 ? ZQ : HID, (const bf16_t*)(ws + (sub == 1 ? WS_WD1 : sub == 7 ? WS_WD2 : WS_WOUT)), M, DM, sub == 5 ? MIXW : FF}; pg8::StaticOrder S; S.init(M, DM, G, (int)blockIdx.x);
            pg8::EpiResid E{XB, (L == 1 && sub == 7) ? X : (float*)nullptr, SSQ, sub == 5 ? 1.0f : 0.5f};
#ifdef PROBE_GEMM2
            { pg8::EpiResid E0{XB, (float*)nullptr, SSQ, 0.0f}; pg8::gemm_phase<pg8::EpiResid, pg8::StaticOrder, true, true>(lds, g, S, E0); __syncthreads(); }
#endif
            pg8::gemm_phase<pg8::EpiResid, pg8::StaticOrder, true, true>(lds, g, S, E);
        } else if (sub == 2) {
            pg8::Gemm g{XB, (const bf16_t*)(ws + WS_WIN), M, 6144, DM}; pg8::StaticOrder S; S.init(M, 6144, G, (int)blockIdx.x);
            pg8::EpiWin E{ZQ, XBC, Kb, Vb, DT, SSQ, INP(13) + L * 64, INP(14) + L * 64, C2, (LAS float*)(lds + 132096)};
#ifdef PROBE_GEMM2
            pg8::gemm_phase<pg8::EpiWin, pg8::StaticOrder, true, true>(lds, g, S, E); __syncthreads();
#endif
            pg8::gemm_phase<pg8::EpiWin, pg8::StaticOrder, true, true>(lds, g, S, E);
            dt_pass(XB, (const bf16_t*)(ws + WS_WIN) + (size_t)6144 * DM, SSQ, DT);
        } else if (sub == 3) {
#ifdef PROBE_SSD2
            for (int item = blockIdx.x; item < BATCH * 16; item += G)
                ssd_item<true>(lds, item, XBC, (bf16_t*)X, DT, ZQ, SSDSS, INP(7) + (size_t)L * 4 * CONVD, INP(8) + (size_t)L * CONVD, INP(9) + L * 16, INP(10) + L * 16, INP(11) + L * 16);
#endif
            for (int item = blockIdx.x; item < BATCH * 16; item += G) ssd_prepass(item, XBC, (bf16_t*)X, INP(7) + (size_t)L * 4 * CONVD, INP(8) + (size_t)L * CONVD);
            xcd_barrier(xbar);
            for (int item = blockIdx.x; item < BATCH * 16; item += G)
                ssd_item<false>(lds, item, XBC, (bf16_t*)X, DT, ZQ, SSDSS, INP(7) + (size_t)L * 4 * CONVD, INP(8) + (size_t)L * CONVD, INP(9) + L * 16, INP(10) + L * 16, INP(11) + L * 16);
        } else {
            __syncthreads();
            attn_phase(lds, ZQ, Kb, Vb, SSDSS, INP(13) + L * 64, INP(14) + L * 64);
        }
    }
}

extern "C" void kernel_launch(void* const* d_in, const int* in_sizes, int n_in, void* d_out, int out_size, void* d_ws, size_t ws_size, hipStream_t stream) {
    static int grid = 0;
    if (grid == 0) {
        if (n_in != 20 || in_sizes[0] != M * DM || out_size != M * DM || ws_size < WS_CTL + CTL_BYTES) { fprintf(stderr, "kernel_launch: unexpected shapes (n_in %d, ws %zu, need %zu)\n", n_in, ws_size, (size_t)WS_END); grid = -1; return; }
        int dev = 0, cus = 0, per_cu = 0;
        hipGetDevice(&dev); hipDeviceGetAttribute(&cus, hipDeviceAttributeMultiprocessorCount, dev);
        if (hipFuncSetAttribute((const void*)hymba_fwd, hipFuncAttributeMaxDynamicSharedMemorySize, LDS_BYTES) != hipSuccess) fprintf(stderr, "kernel_launch: hipFuncSetAttribute failed\n");
        if (hipOccupancyMaxActiveBlocksPerMultiprocessor(&per_cu, (const void*)hymba_fwd, 512, LDS_BYTES) != hipSuccess || per_cu < 1) { fprintf(stderr, "kernel_launch: occupancy query gave %d\n", per_cu); per_cu = 1; }
        (void)hipGetLastError();
        grid = cus * per_cu;
    }
    if (grid < 0) return;
    if (hipMemsetAsync((char*)d_ws + WS_CTL, 0, CTL_BYTES, stream) != hipSuccess) { fprintf(stderr, "kernel_launch: memset failed\n"); return; }
    Args a{};
    for (int i = 0; i < 20; ++i) a.in[i] = (const float*)d_in[i];
    a.out = (float*)d_out; a.ws = (unsigned char*)d_ws; a.ph_lo = 0; a.ph_hi = NPH;
    void* args[] = {&a};
    hipError_t e = hipLaunchCooperativeKernel((const void*)hymba_fwd, dim3(grid), dim3(512), args, LDS_BYTES, stream);
    if (e != hipSuccess) fprintf(stderr, "cooperative launch failed: %s (grid %d)\n", hipGetErrorString(e), grid);
}
```

```cpp
#include <hip/hip_runtime.h>
#include <hip/hip_cooperative_groups.h>
#include <cstdio>
#include <cstdint>
namespace cg = cooperative_groups;
namespace pg8 {
#define PG8_LAS __attribute__((address_space(3)))
typedef unsigned short bf16_t;
typedef short bf16x8 __attribute__((ext_vector_type(8)));
typedef float f32x4 __attribute__((ext_vector_type(4)));
typedef unsigned u32x4 __attribute__((ext_vector_type(4)));
constexpr int BM = 256, BK = 64, HALF = 128, HTB = HALF * BK * 2  , STAGE_BYTES = 8 * HTB, NXCD = 8, WGM = 4;

__host__ __device__ __forceinline__ int lds_byte(int r, int c) { const int st = (r >> 4) * 2 + (c >> 5), rr = r & 15, cc = c & 31, ob = rr * 64 + cc * 2; return st * 1024 + (ob ^ (((ob >> 9) & 1) << 5)); }
__host__ __device__ __forceinline__ void stage_rc(int b, int& R, int& C) { const int st = b / 1024, sb = b % 1024, swz = sb ^ (((sb >> 9) & 1) << 5); R = (st >> 1) * 16 + swz / 64; C = (st & 1) * 32 + (swz % 64) / 2; }
__host__ __device__ __forceinline__ int perm32(int rho) { const int n = rho >> 4, i = rho & 15; return 8 * (i >> 2) + 4 * n + (i & 3); }

struct Unit { int pm, pn; };
struct Gemm { const bf16_t* A; const bf16_t* Bt; int M, N, K; };

struct StaticOrder {
    int nM, nN, nwg, G, c;
    __host__ __device__ void init(int M, int N, int G_, int c_) { nM = M / BM; nN = N / BM; nwg = nM * nN; G = G_; c = c_; }
    __host__ __device__ bool next(int i, Unit& u) const {
        const long L = (long)i * G + c; if (L >= nwg) return false;
        int wgid = (int)L; { const int q = nwg / NXCD, r = nwg % NXCD, xcd = wgid % NXCD, off = wgid / NXCD; wgid = (xcd < r ? xcd * (q + 1) : r * (q + 1) + (xcd - r) * q) + off; }
        const int nig = WGM * nN, gid = wgid / nig, fm = gid * WGM, gsz = (nM - fm) < WGM ? (nM - fm) : WGM;
        u.pm = fm + ((wgid % nig) % gsz); u.pn = (wgid % nig) / gsz; return true;
    }
    __device__ __forceinline__ void a_ready(const Unit&) const {}
    __device__ __forceinline__ void done(const Unit&) const {}
};

__device__ __forceinline__ unsigned cvt_pk_bf16(float lo, float hi) { unsigned r; asm volatile("v_cvt_pk_bf16_f32 %0, %1, %2" : "=v"(r) : "v"(lo), "v"(hi)); return r; }
typedef unsigned u32x2 __attribute__((ext_vector_type(2)));
__device__ __forceinline__ float row_rs(const float* ssq, int row) {
    const f32x4* p = (const f32x4*)(ssq + (size_t)row * 16);
    const f32x4 a = p[0], b = p[1], c = p[2], d = p[3];
    const float s = ((a[0] + a[1]) + (a[2] + a[3])) + ((b[0] + b[1]) + (b[2] + b[3])) + ((c[0] + c[1]) + (c[2] + c[3])) + ((d[0] + d[1]) + (d[2] + d[3]));
    return __builtin_amdgcn_rsqf(s * (1.0f / 1024.0f) + 1e-6f);
}
struct RsPrefetch {
    f32x4 p[4]; bool on;
    __device__ __forceinline__ void issue(const float* ssq, int pm, int wr, int wc, int fr, int fq, bool has) {
        const int wid = wr * 4 + wc, lane = fq * 16 + fr; on = has && lane < 32;
        if (on) { const f32x4* q = (const f32x4*)(ssq + (size_t)(pm * BM + 32 * wid + lane) * 16); p[0] = q[0]; p[1] = q[1]; p[2] = q[2]; p[3] = q[3]; }
    }
    __device__ __forceinline__ void commit(PG8_LAS float* tab, int wr, int wc, int fr, int fq) const {
        const int wid = wr * 4 + wc, lane = fq * 16 + fr;
        if (on) { const f32x4 c = (p[0] + p[1]) + (p[2] + p[3]); tab[32 * wid + lane] = __builtin_amdgcn_rsqf(((c[0] + c[1]) + (c[2] + c[3])) * (1.0f / 1024.0f) + 1e-6f); }
    }
};
__device__ __forceinline__ float silu_f(float x) { return x * __builtin_amdgcn_rcpf(1.0f + __builtin_amdgcn_exp2f(-1.4426950408889634f * x)); }

struct EpiSwiGLU {
    static constexpr bool PERM = true, AFTER_DRAIN = false;
    bf16_t* H; const float* ssq; int ldh; PG8_LAS float* rstab;
    __device__ __forceinline__ void operator()(const f32x4 (&acc)[2][2][4][2], const Unit& u, const Unit& un, bool has_next, int ui, int wr, int wc, int fr, int fq) const {
        const int row0 = u.pm * BM + wr * 64 + fr, col0 = u.pn * 128 + wc * 32 + 8 * fq;
        RsPrefetch rp; rp.issue(ssq, un.pm, wr, wc, fr, fq, has_next);
        const PG8_LAS float* rst = rstab + (ui & 1) * 256;
#pragma unroll
        for (int ai = 0; ai < 2; ++ai)
#pragma unroll
            for (int m = 0; m < 4; ++m) {
                const int row = row0 + ai * HALF + m * 16; const float rs = rst[ai * HALF + wr * 64 + m * 16 + fr];
                const float c1 = -1.4426950408889634f * rs, rs2 = rs * rs;
                const f32x4 G0 = acc[ai][0][m][0], G1 = acc[ai][0][m][1];
                f32x4 e0 = G0 * c1, e1 = G1 * c1;
#pragma unroll
                for (int j = 0; j < 4; ++j) { e0[j] = __builtin_amdgcn_exp2f(e0[j]); e1[j] = __builtin_amdgcn_exp2f(e1[j]); }
                e0 = e0 + 1.0f; e1 = e1 + 1.0f;
#pragma unroll
                for (int j = 0; j < 4; ++j) { e0[j] = __builtin_amdgcn_rcpf(e0[j]); e1[j] = __builtin_amdgcn_rcpf(e1[j]); }
                const f32x4 o0 = (G0 * acc[ai][1][m][0]) * (e0 * rs2), o1 = (G1 * acc[ai][1][m][1]) * (e1 * rs2);
                u32x4 w;
                w.x = cvt_pk_bf16(o0[0], o0[1]); w.y = cvt_pk_bf16(o0[2], o0[3]); w.z = cvt_pk_bf16(o1[0], o1[1]); w.w = cvt_pk_bf16(o1[2], o1[3]);
                __builtin_nontemporal_store(w, (u32x4*)(H + (size_t)row * ldh + col0));
                asm volatile("" ::: "memory");
            }
        rp.commit(rstab + ((ui + 1) & 1) * 256, wr, wc, fr, fq);
    }
    __device__ __forceinline__ void prime(const Unit& u, int wr, int wc, int fr, int fq) const { RsPrefetch rp; rp.issue(ssq, u.pm, wr, wc, fr, fq, true); rp.commit(rstab, wr, wc, fr, fq); }
};
struct EpiResid {
    static constexpr bool PERM = true, AFTER_DRAIN = false;
    bf16_t* XB; float* OUT; float* ssq; float alpha;
    __device__ __forceinline__ void operator()(const f32x4 (&acc)[2][2][4][2], const Unit& u, const Unit& un, bool has_next, int ui, int wr, int wc, int fr, int fq) const {
        const int row0 = u.pm * BM + wr * 64 + fr, col0 = u.pn * BM + wc * 64 + 8 * fq;
#pragma unroll
        for (int ai = 0; ai < 2; ++ai)
#pragma unroll
            for (int m = 0; m < 4; ++m) {
                const int row = row0 + ai * HALF + m * 16; float ss = 0.f;
#pragma unroll
                for (int bj = 0; bj < 2; ++bj) {
                    const size_t off = (size_t)row * 1024 + col0 + bj * 32;
                    const u32x4 r = *(const u32x4*)(XB + off);
                    f32x4 x0, x1;
                    x0[0] = __builtin_bit_cast(float, r.x << 16); x0[1] = __builtin_bit_cast(float, r.x & 0xffff0000u); x0[2] = __builtin_bit_cast(float, r.y << 16); x0[3] = __builtin_bit_cast(float, r.y & 0xffff0000u);
                    x1[0] = __builtin_bit_cast(float, r.z << 16); x1[1] = __builtin_bit_cast(float, r.z & 0xffff0000u); x1[2] = __builtin_bit_cast(float, r.w << 16); x1[3] = __builtin_bit_cast(float, r.w & 0xffff0000u);
                    x0 = x0 + acc[ai][bj][m][0] * alpha; x1 = x1 + acc[ai][bj][m][1] * alpha;
                    u32x4 w; w.x = cvt_pk_bf16(x0[0], x0[1]); w.y = cvt_pk_bf16(x0[2], x0[3]); w.z = cvt_pk_bf16(x1[0], x1[1]); w.w = cvt_pk_bf16(x1[2], x1[3]);
                    *(u32x4*)(XB + off) = w;
                    if (OUT) { *(f32x4*)(OUT + off) = x0; *(f32x4*)(OUT + off + 4) = x1; }
                    ss += ((x0[0] * x0[0] + x0[1] * x0[1]) + (x0[2] * x0[2] + x0[3] * x0[3])) + ((x1[0] * x1[0] + x1[1] * x1[1]) + (x1[2] * x1[2] + x1[3] * x1[3]));
                }
                ss += __shfl_xor(ss, 16); ss += __shfl_xor(ss, 32);
                if (fq == 0) ssq[(size_t)row * 16 + u.pn * 4 + wc] = ss;
                asm volatile("" ::: "memory");
            }
    }
    __device__ __forceinline__ void prime(const Unit&, int, int, int, int) const {}
};
struct EpiWin {
    static constexpr bool PERM = true, AFTER_DRAIN = false;
    bf16_t* ZQ; bf16_t* XBC; bf16_t* Kb; bf16_t* Vb; float* DT; const float* ssq; const float* qw; const float* kw; float qscale; PG8_LAS float* rstab;
    __device__ __forceinline__ void operator()(const f32x4 (&acc)[2][2][4][2], const Unit& u, const Unit& un, bool has_next, int ui, int wr, int wc, int fr, int fq) const {
        const int row0 = u.pm * BM + wr * 64 + fr; const int pn = u.pn;
        RsPrefetch rp; rp.issue(ssq, un.pm, wr, wc, fr, fq, has_next);
        const PG8_LAS float* rst = rstab + (ui & 1) * 256;
        if (pn < 12 || (pn >= 20 && pn < 24)) {
            bf16_t* base; int ld, colt;
            if (pn < 4) { base = ZQ; ld = 2048; colt = 256 * pn; } else if (pn < 12) { base = XBC; ld = 2048; colt = 256 * (pn - 4); } else { base = Vb; ld = 1024; colt = 256 * (pn - 20); }
            const int col0 = colt + wc * 64 + 8 * fq;
#pragma unroll
            for (int ai = 0; ai < 2; ++ai)
#pragma unroll
                for (int m = 0; m < 4; ++m) {
                    const int row = row0 + ai * HALF + m * 16; const float rs = rst[ai * HALF + wr * 64 + m * 16 + fr]; bf16_t* rowp = base + (size_t)row * ld + col0;
#pragma unroll
                    for (int bj = 0; bj < 2; ++bj) { const f32x4 v0 = acc[ai][bj][m][0] * rs, v1 = acc[ai][bj][m][1] * rs;
                        u32x4 w; w.x = cvt_pk_bf16(v0[0], v0[1]); w.y = cvt_pk_bf16(v0[2], v0[3]); w.z = cvt_pk_bf16(v1[0], v1[1]); w.w = cvt_pk_bf16(v1[2], v1[3]);
                        bf16_t* dstp = rowp + bj * 32;
                        if (pn >= 20) dstp = Vb + ((size_t)((row >> 11) * 16 + 4 * (pn - 20) + wc) * 2048 + (row & 2047)) * 64 + 32 * bj + 8 * fq;
                        __builtin_nontemporal_store(w, (u32x4*)dstp); }
                    asm volatile("" ::: "memory");
                }
        } else if (pn < 20) {
            const bool isq = pn < 16; const float* wgt = isq ? qw : kw; const float osc = isq ? qscale : 1.0f;
            bf16_t* base = isq ? ZQ : Kb; const int ld = isq ? 2048 : 1024; const int head = 4 * (pn - (isq ? 12 : 16)) + wc;
            const int col0 = (isq ? 1024 : 0) + head * 64 + 8 * fq;
            f32x4 wv[2][2];
#pragma unroll
            for (int bj = 0; bj < 2; ++bj)
#pragma unroll
                for (int n = 0; n < 2; ++n) wv[bj][n] = *(const f32x4*)(wgt + 32 * bj + 8 * fq + 4 * n) * osc;
#pragma unroll
            for (int ai = 0; ai < 2; ++ai)
#pragma unroll
                for (int m = 0; m < 4; ++m) {
                    const int row = row0 + ai * HALF + m * 16; const float rs = rst[ai * HALF + wr * 64 + m * 16 + fr];
                    bf16_t* rowp = isq ? base + (size_t)row * ld + col0 : Kb + ((size_t)((row >> 11) * 16 + head) * 2048 + (row & 2047)) * 64 + 8 * fq;
                    f32x4 v[2][2]; float ss = 0.f;
#pragma unroll
                    for (int bj = 0; bj < 2; ++bj)
#pragma unroll
                        for (int n = 0; n < 2; ++n) { v[bj][n] = acc[ai][bj][m][n] * rs; const f32x4 t = v[bj][n]; ss += (t[0] * t[0] + t[1] * t[1]) + (t[2] * t[2] + t[3] * t[3]); }
                    ss += __shfl_xor(ss, 16); ss += __shfl_xor(ss, 32);
                    const float rn = __builtin_amdgcn_rsqf(ss * (1.0f / 64.0f) + 1e-6f);
#pragma unroll
                    for (int bj = 0; bj < 2; ++bj) { const f32x4 v0 = v[bj][0] * wv[bj][0] * rn, v1 = v[bj][1] * wv[bj][1] * rn;
                        u32x4 w; w.x = cvt_pk_bf16(v0[0], v0[1]); w.y = cvt_pk_bf16(v0[2], v0[3]); w.z = cvt_pk_bf16(v1[0], v1[1]); w.w = cvt_pk_bf16(v1[2], v1[3]);
                        __builtin_nontemporal_store(w, (u32x4*)(rowp + bj * 32)); }
                    asm volatile("" ::: "memory");
                }
        } else {
            if (wc == 0 && fq < 2) {
#pragma unroll
                for (int ai = 0; ai < 2; ++ai)
#pragma unroll
                    for (int m = 0; m < 4; ++m) {
                        const int row = row0 + ai * HALF + m * 16; const float rs = rst[ai * HALF + wr * 64 + m * 16 + fr];
                        *(f32x4*)(DT + (size_t)row * 16 + 8 * fq) = acc[ai][0][m][0] * rs; *(f32x4*)(DT + (size_t)row * 16 + 8 * fq + 4) = acc[ai][0][m][1] * rs;
                        asm volatile("" ::: "memory");
                    }
            }
        }
        rp.commit(rstab + ((ui + 1) & 1) * 256, wr, wc, fr, fq);
    }
    __device__ __forceinline__ void prime(const Unit& u, int wr, int wc, int fr, int fq) const { RsPrefetch rp; rp.issue(ssq, u.pm, wr, wc, fr, fq, true); rp.commit(rstab, wr, wc, fr, fq); }
};
__device__ __forceinline__ void glds16_s(const void* sbase, unsigned voff, unsigned lds_dst) {
    asm volatile("s_mov_b32 m0, %2\n\ts_nop 0\n\tglobal_load_lds_dwordx4 %0, %1" : : "v"(voff), "s"(sbase), "s"(lds_dst) : "memory"); }
template <class Epi, class Sched, bool ALIGN_EPI = false, bool SP2 = false>
__device__ __forceinline__ void gemm_phase(PG8_LAS unsigned char* lds, const Gemm g, const Sched& S, const Epi& E) {
    int tid_l = threadIdx.x; asm volatile("" : "+v"(tid_l));
    const int tid = tid_l, wid = __builtin_amdgcn_readfirstlane(tid >> 6), lane = tid & 63, wr = wid >> 2, wc = wid & 3, fr = lane & 15, fq = lane >> 4;
    const int K = g.K, nt = K / BK;
    unsigned voffA[2], voffB[2];
#pragma unroll
    for (int i = 0; i < 2; ++i) { int R, C; stage_rc(tid * 16 + i * 8192, R, C); const int Rb = Epi::PERM ? ((R & ~31) + perm32(R & 31)) : R;
        voffA[i] = (unsigned)(R * K + C) * 2u; voffB[i] = (unsigned)(Rb * K + C) * 2u; }
    const size_t kstep = (size_t)(BK * 2);
    const size_t hstep = (size_t)HALF * K * 2;
    const size_t tstep = 2 * hstep;
    const unsigned ldsbase = (unsigned)(uintptr_t)lds;
    const unsigned ldsw = (unsigned)wid * 1024u;
    const int aoff = lds_byte(wr * 64 + fr, fq * 8), boff = lds_byte(wc * 32 + fr, fq * 8);
#define PG8_SA(b, h) (((b) * 2 + (h)) * HTB)
#define PG8_SB(b, h) ((4 + (b) * 2 + (h)) * HTB)
#define PG8_STAGE(bufoff, gbase, voff) do { _Pragma("unroll") for (int _i = 0; _i < 2; ++_i) \
        glds16_s((const void*)(gbase), (voff)[_i], ldsbase + (unsigned)(bufoff) + ldsw + _i * 8192u); } while (0)
#define PG8_LDA(dst, b, h) do { _Pragma("unroll") for (int m = 0; m < 4; ++m) _Pragma("unroll") for (int k = 0; k < 2; ++k) dst[m][k] = *(const PG8_LAS bf16x8*)(lds + PG8_SA(b, h) + aoff + m * 2048 + k * 1024); } while (0)
#define PG8_LDB(dst, b, h) do { _Pragma("unroll") for (int n = 0; n < 2; ++n) _Pragma("unroll") for (int k = 0; k < 2; ++k) dst[n][k] = *(const PG8_LAS bf16x8*)(lds + PG8_SB(b, h) + boff + n * 2048 + k * 1024); } while (0)
#define PG8_MMA(ai, bj, At, Bt) do { __builtin_amdgcn_s_setprio(1); _Pragma("unroll") for (int m = 0; m < 4; ++m) _Pragma("unroll") for (int n = 0; n < 2; ++n) _Pragma("unroll") for (int k = 0; k < 2; ++k) \
        acc[ai][bj][m][n] = __builtin_amdgcn_mfma_f32_16x16x32_bf16(Bt[n][k], At[m][k], acc[ai][bj][m][n], 0, 0, 0); __builtin_amdgcn_s_setprio(0); } while (0)
#define PG8_WAIT_V(n) asm volatile("s_waitcnt vmcnt(" #n ")" ::: "memory")
#define PG8_WAIT_L(n) asm volatile("s_waitcnt lgkmcnt(" #n ")" ::: "memory")
#define PG8_BAR __builtin_amdgcn_s_barrier()
#define PG8_SCHED __builtin_amdgcn_sched_barrier(0)
    Unit cur, nxt; int ui = 0;
    if (!S.next(0, cur)) return;
    f32x4 acc[2][2][4][2];
#pragma unroll
    for (int a = 0; a < 2; ++a)
#pragma unroll
        for (int b = 0; b < 2; ++b)
#pragma unroll
            for (int m = 0; m < 4; ++m)
#pragma unroll
                for (int n = 0; n < 2; ++n) acc[a][b][m][n] = (f32x4){0.f, 0.f, 0.f, 0.f};
    bf16x8 At[4][2], B0[2][2], B1[2][2];
    const char* cA = (const char*)g.A + (size_t)cur.pm * tstep; const char* cB = (const char*)g.Bt + (size_t)cur.pn * tstep;
    S.a_ready(cur);
    E.prime(cur, wr, wc, fr, fq);
    if constexpr (SP2) {
        PG8_STAGE(PG8_SB(0, 0), cB, voffB); PG8_STAGE(PG8_SB(0, 1), cB + hstep, voffB); PG8_STAGE(PG8_SA(0, 0), cA, voffA); PG8_STAGE(PG8_SA(0, 1), cA + hstep, voffA);
        if (wr == 1) PG8_BAR;
        PG8_WAIT_V(2); PG8_BAR;
        PG8_STAGE(PG8_SB(1, 0), cB + kstep, voffB); PG8_STAGE(PG8_SA(1, 0), cA + kstep, voffA); PG8_STAGE(PG8_SB(1, 1), cB + hstep + kstep, voffB);
        PG8_WAIT_V(6); PG8_BAR;
    } else {
        PG8_STAGE(PG8_SB(0, 0), cB, voffB); PG8_STAGE(PG8_SA(0, 0), cA, voffA); PG8_STAGE(PG8_SB(0, 1), cB + hstep, voffB); PG8_STAGE(PG8_SA(0, 1), cA + hstep, voffA);
        if (wr == 1) PG8_BAR;
        PG8_WAIT_V(4); PG8_BAR;
        PG8_STAGE(PG8_SB(1, 0), cB + kstep, voffB); PG8_STAGE(PG8_SA(1, 0), cA + kstep, voffA); PG8_STAGE(PG8_SB(1, 1), cB + hstep + kstep, voffB);
        PG8_WAIT_V(6); PG8_BAR;
    }
    for (;;) {
        const bool has_next = S.next(ui + 1, nxt);
        const char* nA = has_next ? (const char*)g.A + (size_t)nxt.pm * tstep : cA; const char* nB = has_next ? (const char*)g.Bt + (size_t)nxt.pn * tstep : cB;
        for (int t = 0; t < nt; t += 2) {
            const bool last = (t == nt - 2);
            const char* a1 = cA + (size_t)(t + 1) * kstep;
            const char* a2 = last ? nA : cA + (size_t)(t + 2) * kstep; const char* b2 = last ? nB : cB + (size_t)(t + 2) * kstep;
            const char* a3 = a2 + kstep; const char* b3 = b2 + kstep;
            if (last && has_next) S.a_ready(nxt);
            if constexpr (SP2) {
            PG8_LDB(B0, 0, 0); PG8_LDB(B1, 0, 1); PG8_SCHED; PG8_LDA(At, 0, 0); PG8_STAGE(PG8_SA(1, 1), a1 + hstep, voffA);
            PG8_WAIT_V(8); PG8_WAIT_L(0); PG8_BAR; PG8_MMA(0, 0, At, B0); PG8_MMA(0, 1, At, B1); PG8_BAR; PG8_SCHED;
            PG8_LDA(At, 0, 1); PG8_STAGE(PG8_SB(0, 0), b2, voffB); PG8_STAGE(PG8_SB(0, 1), b2 + hstep, voffB); PG8_STAGE(PG8_SA(0, 0), a2, voffA);
            PG8_WAIT_V(8); PG8_WAIT_L(0); PG8_BAR; PG8_MMA(1, 0, At, B0); PG8_MMA(1, 1, At, B1); PG8_BAR; PG8_SCHED;
            PG8_LDB(B0, 1, 0); PG8_LDB(B1, 1, 1); PG8_SCHED; PG8_LDA(At, 1, 0); PG8_STAGE(PG8_SA(0, 1), a2 + hstep, voffA);
            PG8_WAIT_V(8); PG8_WAIT_L(0); PG8_BAR; PG8_MMA(0, 0, At, B0); PG8_MMA(0, 1, At, B1); PG8_BAR; PG8_SCHED;
            PG8_LDA(At, 1, 1); PG8_STAGE(PG8_SB(1, 0), b3, voffB); PG8_STAGE(PG8_SB(1, 1), b3 + hstep, voffB); PG8_STAGE(PG8_SA(1, 0), a3, voffA);
            PG8_WAIT_V(8); PG8_WAIT_L(0); PG8_BAR; PG8_MMA(1, 0, At, B0); PG8_MMA(1, 1, At, B1); PG8_BAR; PG8_SCHED;
            } else {
            PG8_LDB(B0, 0, 0); PG8_SCHED; PG8_LDA(At, 0, 0); PG8_STAGE(PG8_SA(1, 1), a1 + hstep, voffA);
            PG8_WAIT_L(8); PG8_BAR; PG8_WAIT_L(0); PG8_MMA(0, 0, At, B0); PG8_BAR; PG8_SCHED;
            PG8_LDB(B1, 0, 1); PG8_STAGE(PG8_SB(0, 0), b2, voffB);
            PG8_BAR; PG8_WAIT_L(0); PG8_MMA(0, 1, At, B1); PG8_BAR;
            PG8_LDA(At, 0, 1); PG8_STAGE(PG8_SA(0, 0), a2, voffA);
            PG8_BAR; PG8_WAIT_L(0); PG8_MMA(1, 0, At, B0); PG8_BAR; PG8_SCHED;
            PG8_STAGE(PG8_SB(0, 1), b2 + hstep, voffB);
            PG8_WAIT_V(6); PG8_BAR; PG8_MMA(1, 1, At, B1); PG8_BAR;
            PG8_LDB(B0, 1, 0); PG8_SCHED; PG8_LDA(At, 1, 0); PG8_STAGE(PG8_SA(0, 1), a2 + hstep, voffA);
            PG8_WAIT_L(8); PG8_BAR; PG8_WAIT_L(0); PG8_MMA(0, 0, At, B0); PG8_BAR; PG8_SCHED;
            PG8_LDB(B1, 1, 1); PG8_STAGE(PG8_SB(1, 0), b3, voffB);
            PG8_BAR; PG8_WAIT_L(0); PG8_MMA(0, 1, At, B1); PG8_BAR;
            PG8_LDA(At, 1, 1); PG8_STAGE(PG8_SA(1, 0), a3, voffA);
            PG8_BAR; PG8_WAIT_L(0); PG8_MMA(1, 0, At, B0); PG8_BAR; PG8_SCHED;
            PG8_STAGE(PG8_SB(1, 1), b3 + hstep, voffB);
            PG8_WAIT_V(6); PG8_BAR; PG8_MMA(1, 1, At, B1); PG8_BAR;
            }
        }
        if constexpr (ALIGN_EPI) { if (wr == 0) PG8_BAR; }
        if constexpr (!Epi::AFTER_DRAIN) { E(acc, cur, nxt, has_next, ui, wr, wc, fr, fq); S.done(cur); }
        if (!has_next) break;
#pragma unroll
        for (int a = 0; a < 2; ++a)
#pragma unroll
            for (int b = 0; b < 2; ++b)
#pragma unroll
                for (int m = 0; m < 4; ++m)
#pragma unroll
                    for (int n = 0; n < 2; ++n) acc[a][b][m][n] = (f32x4){0.f, 0.f, 0.f, 0.f};
        cur = nxt; cA = nA; cB = nB; ++ui;
        if constexpr (ALIGN_EPI) { if (wr == 1) PG8_BAR; }
    }
    PG8_WAIT_V(0);
    if constexpr (!ALIGN_EPI) { if (wr == 0) PG8_BAR; }
    PG8_BAR;
    if constexpr (Epi::AFTER_DRAIN) { E.fused(acc, cur, wr, wc, fr, fq, lds, wid, lane); S.done(cur); }
#undef PG8_SA
#undef PG8_SB
#undef PG8_STAGE
#undef PG8_LDA
#undef PG8_LDB
#undef PG8_MMA
#undef PG8_WAIT_V
#undef PG8_WAIT_L
#undef PG8_BAR
#undef PG8_SCHED
}
}
#define LAS __attribute__((address_space(3)))
typedef unsigned short bf16_t;
typedef float f32x4 __attribute__((ext_vector_type(4)));
typedef float f32x2 __attribute__((ext_vector_type(2)));
typedef unsigned u32x4v __attribute__((ext_vector_type(4)));
typedef unsigned u32x2v __attribute__((ext_vector_type(2)));
constexpr int BATCH = 16, SEQ = 2048, DM = 1024, FF = 2816, NGU = 2 * FF, INPW = 6160, NIN = 6400, MIXW = 2048, CONVD = 2048;
constexpr int M = BATCH * SEQ;
constexpr int NPH = 17;
constexpr float C2 = 0.125f * 1.4426950408889634f;
constexpr size_t SZ_WGU = (size_t)NGU * DM * 2, SZ_WD = (size_t)DM * FF * 2, SZ_WIN = (size_t)NIN * DM * 2, SZ_WOUT = (size_t)DM * MIXW * 2;
constexpr size_t WS_WGU1 = 0, WS_WD1 = WS_WGU1 + SZ_WGU, WS_WIN = WS_WD1 + SZ_WD, WS_WOUT = WS_WIN + SZ_WIN, WS_WGU2 = WS_WOUT + SZ_WOUT, WS_WD2 = WS_WGU2 + SZ_WGU;
constexpr size_t WS_SSQ = WS_WD2 + SZ_WD, WS_DT = WS_SSQ + (size_t)M * 64, WS_SSDSS = WS_DT + (size_t)M * 64, WS_XB = WS_SSDSS + (size_t)M * 64;
constexpr size_t WS_BIG = WS_XB + (size_t)M * DM * 2;
constexpr size_t WS_ZQ = WS_BIG, WS_XBC = WS_ZQ + (size_t)M * 2048 * 2, WS_K = WS_XBC + (size_t)M * 2048 * 2, WS_V = WS_K + (size_t)M * 1024 * 2, WS_END = WS_V + (size_t)M * 1024 * 2;
constexpr size_t WS_HID = WS_BIG;
static_assert(WS_HID + (size_t)M * FF * 2 <= WS_K, "hid overlay");
constexpr size_t WS_CTL = WS_END, CTL_BYTES = 16384;
static_assert(WS_CTL + CTL_BYTES <= 536870912ull, "workspace");
constexpr int LDS_BYTES = 147456;

__device__ __forceinline__ unsigned f2bf(float f) { unsigned u = __builtin_bit_cast(unsigned, f); return (u + 0x7fffu + ((u >> 16) & 1u)) >> 16; }
typedef __bf16 bf16x2_t __attribute__((ext_vector_type(2)));
__device__ __forceinline__ unsigned pk2(float lo, float hi) { f32x2 v = {lo, hi}; bf16x2_t b = __builtin_convertvector(v, bf16x2_t); return __builtin_bit_cast(unsigned, b); }
__device__ __forceinline__ f32x4 bf4_to_f32(u32x2v r) { f32x4 o; o[0] = __builtin_bit_cast(float, r.x << 16); o[1] = __builtin_bit_cast(float, r.x & 0xffff0000u); o[2] = __builtin_bit_cast(float, r.y << 16); o[3] = __builtin_bit_cast(float, r.y & 0xffff0000u); return o; }
__device__ __forceinline__ float wave_sum(float v) {
#pragma unroll
    for (int o = 1; o < 64; o <<= 1) v += __shfl_xor(v, o);
    return v;
}
template <int CTRL> __device__ __forceinline__ float dpp_f(float v) { return __builtin_bit_cast(float, __builtin_amdgcn_update_dpp(0, __builtin_bit_cast(int, v), CTRL, 0xF, 0xF, true)); }
__device__ __forceinline__ float row16_sum(float y) { y += dpp_f<0xB1>(y); y += dpp_f<0x4E>(y); y += dpp_f<0x141>(y); y += dpp_f<0x140>(y); return y; }
__device__ __forceinline__ float sigmoid_f(float x) { return __builtin_amdgcn_rcpf(1.0f + __builtin_amdgcn_exp2f(-1.4426950408889634f * x)); }

enum { MAP_ID = 0, MAP_GU = 1, MAP_WIN = 2, MAP_RES = 3 };
__device__ __forceinline__ void conv_item(const float* W0, const float* W1, int K, int Nsrc, bf16_t* WT, int Ndst, const float* kscale, int kslim, int kind, LAS float* scr, int item, int lane) {
    const int nblk = Ndst / 32, kb = item / nblk, nb = item % nblk, k0 = 64 * kb;
    const float* W = W0; int src = 32 * nb, nv = 32;
    if (kind == MAP_GU) { const int pn = nb >> 3, bi = nb & 7; W = (bi >> 2) ? W1 : W0; src = 128 * pn + 32 * (bi & 3); }
    else if (kind == MAP_RES) { const int pn = nb >> 3, bi = nb & 7; src = 256 * pn + 64 * (bi & 3) + 32 * (bi >> 2); }
    else if (kind == MAP_WIN) { const int pn = nb >> 3, bi = nb & 7, bj = bi >> 2, wc = bi & 3;
        if (pn < 4) src = 256 * pn + 64 * wc + 32 * bj;
        else if (pn < 12) src = 1024 + 256 * (pn - 4) + 64 * wc + 32 * bj;
        else if (pn < 16) src = 3088 + 256 * (pn - 12) + 64 * wc + 32 * bj;
        else if (pn < 20) src = 4112 + 256 * (pn - 16) + 64 * wc + 32 * bj;
        else if (pn < 24) src = 5136 + 256 * (pn - 20) + 64 * wc + 32 * bj;
        else { src = 3072; nv = (bi == 0) ? 16 : 0; } }
    const int n4 = 4 * (lane & 7);
    f32x4 v[8];
#pragma unroll
    for (int i = 0; i < 8; ++i) { const int kk = 8 * i + (lane >> 3); v[i] = (f32x4){0.f, 0.f, 0.f, 0.f};
        if (n4 < nv) { v[i] = *(const f32x4*)(W + (size_t)(k0 + kk) * Nsrc + src + n4); if (kscale && (k0 + kk) < kslim) v[i] = v[i] * kscale[k0 + kk]; } }
#pragma unroll
    for (int i = 0; i < 8; ++i) { const int kk = 8 * i + (lane >> 3); *(LAS f32x4*)(scr + kk * 36 + n4) = v[i]; }
    asm volatile("s_waitcnt lgkmcnt(0)" ::: "memory");
    const int c = lane & 7;
#pragma unroll
    for (int j = 0; j < 4; ++j) { const int nn = (lane >> 3) + 8 * j; const LAS float* s = scr + (8 * c) * 36 + nn;
        u32x4v o; o.x = pk2(s[0 * 36], s[1 * 36]); o.y = pk2(s[2 * 36], s[3 * 36]); o.z = pk2(s[4 * 36], s[5 * 36]); o.w = pk2(s[6 * 36], s[7 * 36]);
        *(u32x4v*)(WT + (size_t)(32 * nb + nn) * K + k0 + 8 * c) = o; }
    asm volatile("s_waitcnt lgkmcnt(0)" ::: "memory");
}
struct Args { const float* in[20]; float* out; unsigned char* ws; int ph_lo, ph_hi; };
#define PTAB_OFF 146432
__device__ __forceinline__ const float* in_ptr(LAS unsigned char* lds, int i) { const LAS unsigned* p = (const LAS unsigned*)(lds + PTAB_OFF) + 2 * i; const unsigned lo = __builtin_amdgcn_readfirstlane(p[0]), hi = __builtin_amdgcn_readfirstlane(p[1]); return (const float*)(((unsigned long long)hi << 32) | lo); }
#define INP(i) in_ptr(lds, (i))
__device__ __forceinline__ void convert_weight(unsigned char* ws, int which, int L, LAS unsigned char* lds) {
    int tid_l = threadIdx.x; asm volatile("" : "+v"(tid_l));
    const int lane = tid_l & 63, wid = tid_l >> 6;
    LAS float* scr = (LAS float*)(lds + wid * 16384);
    const int gw = blockIdx.x * 8 + wid, NGW = gridDim.x * 8;
    const float* W0; const float* W1 = nullptr; int K, Nsrc, Ndst, kind, kslim = 1 << 30; const float* ks = nullptr; bf16_t* WT;
    if (which == 0 || which == 4) { const int o = which == 0 ? 0 : 15; W0 = INP(2 + o) + (size_t)L * DM * FF; W1 = INP(3 + o) + (size_t)L * DM * FF; ks = INP(1 + o) + L * DM;
        K = DM; Nsrc = FF; Ndst = NGU; kind = MAP_GU; WT = (bf16_t*)(ws + (which == 0 ? WS_WGU1 : WS_WGU2)); }
    else if (which == 1 || which == 5) { W0 = INP(which == 1 ? 4 : 19) + (size_t)L * FF * DM; K = FF; Nsrc = DM; Ndst = DM; kind = MAP_RES; WT = (bf16_t*)(ws + (which == 1 ? WS_WD1 : WS_WD2)); }
    else if (which == 2) { W0 = INP(6) + (size_t)L * DM * INPW; ks = INP(5) + L * DM; K = DM; Nsrc = INPW; Ndst = NIN; kind = MAP_WIN; WT = (bf16_t*)(ws + WS_WIN); }
    else { W0 = INP(15) + (size_t)L * MIXW * DM; ks = INP(12) + L * 1024; kslim = 1024; K = MIXW; Nsrc = DM; Ndst = DM; kind = MAP_RES; WT = (bf16_t*)(ws + WS_WOUT); }
    const int items = (K / 64) * (Ndst / 32);
    for (int it = gw; it < items; it += NGW) conv_item(W0, W1, K, Nsrc, WT, Ndst, ks, kslim, kind, scr, it, lane);
}

constexpr int ST = 32, NWIN = SEQ / ST;
constexpr int RSB = 272, RSX = 144, RSH = 272;
constexpr int IMG_B = 0, IMG_C = 32 * RSB, IMG_X = 2 * 32 * RSB, IMG_A = IMG_X + 32 * RSX, IMG_BYTES = IMG_A + 128;
constexpr int SSD_CW = 0, SSD_IMG = 6400, SSD_H = SSD_IMG + 2 * IMG_BYTES, SSD_XS = SSD_H + 2 * 64 * RSH, SSD_OUT = SSD_XS + 3 * ST * 64 * 4, SSD_END = SSD_OUT + 2 * ST * 64 * 4;
static_assert(SSD_END <= 131072 && (IMG_BYTES % 16) == 0 && (SSD_H % 16) == 0, "SSD LDS map");
constexpr float LOG2E = 1.4426950408889634f;
typedef short bf16x8_t __attribute__((ext_vector_type(8)));
typedef float f32x16 __attribute__((ext_vector_type(16)));
typedef short v4i16_t __attribute__((ext_vector_type(4)));
struct StageRegs { u32x2v rb[4]; u32x2v rx[5]; float dtr[2]; float dtt; };
__device__ __forceinline__ void ssd_stage_load(int wn, int tid, int b, int h, int g, const bf16_t* XBC, const bf16_t* XBA, const float* DT, StageRegs& R) {
    const int t0 = wn * ST, hl = tid - 256;
    { const int bq = tid & 63, seg = tid >> 6; const int ca = (bq < 32 ? 128 * g + 4 * bq : 512 + 128 * g + 4 * (bq - 32));
#pragma unroll
      for (int i = 0; i < 4; ++i) R.rb[i] = *(const u32x2v*)(XBA + ((size_t)(b * SEQ + t0 + 4 * seg + i)) * 1024 + ca); }
    if (hl >= 0) { const int xq = hl & 15, sp = hl >> 4; const int ch = h * 64 + 4 * xq; const int tf = t0 + 2 * sp - 3;
#pragma unroll
      for (int i = 0; i < 5; ++i) { const int tt = tf + i; R.rx[i] = *(const u32x2v*)(XBC + ((size_t)(b * SEQ + (tt < 0 ? 0 : tt))) * CONVD + ch); }
      R.dtr[0] = DT[((size_t)(b * SEQ + t0 + 2 * sp)) * 16 + h]; R.dtr[1] = DT[((size_t)(b * SEQ + t0 + 2 * sp + 1)) * 16 + h];
    }
    if ((tid >> 6) == 2) R.dtt = DT[((size_t)(b * SEQ + t0 + (tid & 31))) * 16 + h];
}
__device__ __forceinline__ f32x4 silu4(f32x4 a) { f32x4 o; o[0] = a[0] * sigmoid_f(a[0]); o[1] = a[1] * sigmoid_f(a[1]); o[2] = a[2] * sigmoid_f(a[2]); o[3] = a[3] * sigmoid_f(a[3]); return o; }
__device__ __forceinline__ float softplus_f(float v) {
    const float e = __builtin_amdgcn_exp2f(v * LOG2E); const float big = __builtin_amdgcn_logf(1.0f + e) * 0.6931471805599453f; const float sm = e * (1.0f - 0.5f * e);
    return v > 20.f ? v : (e < 1e-3f ? sm : big); }
__device__ __forceinline__ void ssd_stage_compute(int wn, int tid, LAS unsigned char* lds, const StageRegs& R, float dtb, float aneg) {
    LAS float* CW = (LAS float*)(lds + SSD_CW); LAS unsigned char* IMG = lds + SSD_IMG + (wn & 1) * IMG_BYTES; LAS float* XS = (LAS float*)(lds + SSD_XS) + (wn % 3) * (ST * 64);
    const int t0 = wn * ST, hl = tid - 256;
    { const int bq = tid & 63, seg = tid >> 6;
      LAS unsigned char* dst = IMG + (bq < 32 ? IMG_B + 8 * bq : IMG_C + 8 * (bq - 32)) + (4 * seg) * RSB;
#pragma unroll
      for (int j = 0; j < 4; ++j) *(LAS u32x2v*)(dst + j * RSB) = R.rb[j]; }
    if (hl >= 0) { const int xq = hl & 15, sp = hl >> 4; const int cwi = 4 * xq; const int tf = t0 + 2 * sp - 3;
      const f32x4 w0 = *(const LAS f32x4*)(CW + cwi), w1 = *(const LAS f32x4*)(CW + 320 + cwi), w2 = *(const LAS f32x4*)(CW + 640 + cwi), w3 = *(const LAS f32x4*)(CW + 960 + cwi), bs = *(const LAS f32x4*)(CW + 1280 + cwi);
      f32x4 x[5];
#pragma unroll
      for (int i = 0; i < 5; ++i) { x[i] = bf4_to_f32(R.rx[i]); if (tf + i < 0) x[i] = (f32x4){0.f, 0.f, 0.f, 0.f}; }
#pragma unroll
      for (int j = 0; j < 2; ++j) { const int s = 2 * sp + j; const f32x4 act = silu4(bs + w0 * x[j] + w1 * x[j + 1] + w2 * x[j + 2] + w3 * x[j + 3]);
          const float dtv = softplus_f(R.dtr[j] + dtb); const f32x4 xd = act * dtv;
          *(LAS f32x4*)(XS + s * 64 + 4 * xq) = act;
          u32x2v o; o.x = pk2(xd[0], xd[1]); o.y = pk2(xd[2], xd[3]); *(LAS u32x2v*)(IMG + IMG_X + s * RSX + 8 * xq) = o; }
    }
    if ((tid >> 6) == 2) {
        float x = softplus_f(R.dtt + dtb) * aneg;
        x += dpp_f<0x111>(x); x += dpp_f<0x112>(x); x += dpp_f<0x114>(x); x += dpp_f<0x118>(x);
        x += __builtin_bit_cast(float, __builtin_amdgcn_update_dpp(0, __builtin_bit_cast(int, x), 0x142, 0xA, 0xF, false));
        if ((tid & 63) < 32) ((LAS float*)(IMG + IMG_A))[tid & 63] = x;
    }
}
struct ZRegs { u32x2v z; };
__device__ __forceinline__ void ssd_loadz(int wz, int tid, int b, int h, const bf16_t* ZQ, ZRegs& Z) {
    const int s = tid >> 4, pq = tid & 15, t = wz * ST + s; Z.z = *(const u32x2v*)(ZQ + ((size_t)(b * SEQ + t)) * 2048 + h * 64 + 4 * pq);
}
template <bool DRY> __device__ __forceinline__ void ssd_post(int wp, int tid, int b, int h, LAS unsigned char* lds, bf16_t* ZQ, float* SSDSS, float Dh, const ZRegs& Z) {
    const LAS float* OUT = (const LAS float*)(lds + SSD_OUT) + (wp & 1) * (ST * 64); const LAS float* XS = (const LAS float*)(lds + SSD_XS) + (wp % 3) * (ST * 64);
    const int s = tid >> 4, pq = tid & 15, t = wp * ST + s;
    const f32x4 y = *(const LAS f32x4*)(OUT + s * 64 + 4 * pq) + *(const LAS f32x4*)(XS + s * 64 + 4 * pq) * Dh;
    bf16_t* zp = ZQ + ((size_t)(b * SEQ + t)) * 2048 + h * 64 + 4 * pq;
    const f32x4 z = bf4_to_f32(Z.z);
    f32x4 yg; yg[0] = y[0] * z[0] * sigmoid_f(z[0]); yg[1] = y[1] * z[1] * sigmoid_f(z[1]); yg[2] = y[2] * z[2] * sigmoid_f(z[2]); yg[3] = y[3] * z[3] * sigmoid_f(z[3]);
    float ss = (yg[0] * yg[0] + yg[1] * yg[1]) + (yg[2] * yg[2] + yg[3] * yg[3]);
    ss = row16_sum(ss);
    u32x2v w; w.x = pk2(yg[0], yg[1]); w.y = pk2(yg[2], yg[3]);
    if (!DRY) { *(u32x2v*)zp = w; if (pq == 0) SSDSS[((size_t)(b * SEQ + t)) * 16 + h] = ss; }
    else if (ss == 12345.678f) { *(u32x2v*)zp = w; }
}
__device__ __forceinline__ bf16x8_t tr_pair(const LAS unsigned char* p0, const LAS unsigned char* p1) {
    const v4i16_t lo = __builtin_amdgcn_ds_read_tr16_b64_v4i16((LAS v4i16_t*)p0), hh = __builtin_amdgcn_ds_read_tr16_b64_v4i16((LAS v4i16_t*)p1);
    return (bf16x8_t){lo[0], lo[1], lo[2], lo[3], hh[0], hh[1], hh[2], hh[3]};
}
__device__ __forceinline__ void ssd_prepass(int item, const bf16_t* XBC, bf16_t* XBA, const float* conv_w, const float* conv_b) {
    int tid = threadIdx.x; asm volatile("" : "+v"(tid));
    const int b = item >> 4, h = item & 15, g = h >> 2;
    const int gq = (h & 3) * 16 + (tid & 15), chunk = tid >> 4;
    const int ch = gq < 32 ? 1024 + 128 * g + 4 * gq : 1536 + 128 * g + 4 * (gq - 32);
    const f32x4 w0 = *(const f32x4*)(conv_w + ch), w1 = *(const f32x4*)(conv_w + CONVD + ch), w2 = *(const f32x4*)(conv_w + 2 * CONVD + ch), w3 = *(const f32x4*)(conv_w + 3 * CONVD + ch), bs = *(const f32x4*)(conv_b + ch);
    const bf16_t* src = XBC + ((size_t)(b * SEQ)) * CONVD + ch; bf16_t* dst = XBA + ((size_t)(b * SEQ)) * 1024 + (ch - 1024);
    const int tb = 64 * chunk;
    f32x4 x0, x1, x2;
    if (tb == 0) { x0 = (f32x4){0.f, 0.f, 0.f, 0.f}; x1 = x0; x2 = x0; }
    else { x0 = bf4_to_f32(*(const u32x2v*)(src + (size_t)(tb - 3) * CONVD)); x1 = bf4_to_f32(*(const u32x2v*)(src + (size_t)(tb - 2) * CONVD)); x2 = bf4_to_f32(*(const u32x2v*)(src + (size_t)(tb - 1) * CONVD)); }
    for (int j0 = 0; j0 < 64; j0 += 8) {
        u32x2v raw[8];
#pragma unroll
        for (int j = 0; j < 8; ++j) raw[j] = *(const u32x2v*)(src + (size_t)(tb + j0 + j) * CONVD);
#pragma unroll
        for (int j = 0; j < 8; ++j) { const f32x4 x3 = bf4_to_f32(raw[j]); const f32x4 a = silu4(bs + w0 * x0 + w1 * x1 + w2 * x2 + w3 * x3);
            u32x2v o; o.x = pk2(a[0], a[1]); o.y = pk2(a[2], a[3]); *(u32x2v*)(dst + (size_t)(tb + j0 + j) * 1024) = o; x0 = x1; x1 = x2; x2 = x3; }
    }
}
template <bool DRY> __device__ __forceinline__ void ssd_window(int w, int tid, int lane, int wid, int b, int h, int g, LAS unsigned char* lds, const bf16_t* XBC, const bf16_t* XBA, const float* DT, bf16_t* ZQ, float* SSDSS,
                                                              float dtb, float aneg, float Dh, f32x16& hacc0, f32x16& hacc1, StageRegs& R, ZRegs& Z) {
    const int c = lane & 31, hi = lane >> 5, q4 = (lane & 15) >> 2, p4 = lane & 3, g1 = (lane >> 4) & 1;
    const int pt = wid & 1, ntb = 2 * ((wid >> 1) & 1);
        if (wid < 4) {
            __builtin_amdgcn_s_setprio(3);
            const LAS unsigned char* IMG = lds + SSD_IMG + (w & 1) * IMG_BYTES;
            const LAS unsigned char* Bi = IMG + IMG_B; const LAS unsigned char* Ci = IMG + IMG_C; const LAS unsigned char* Xi = IMG + IMG_X; const LAS float* AC = (const LAS float*)(IMG + IMG_A);
            const LAS unsigned char* Hc = lds + SSD_H + (w & 1) * (64 * RSH); LAS unsigned char* Hn = lds + SSD_H + ((w + 1) & 1) * (64 * RSH);
            const float aT = AC[31];
            if (wid < 2) {
                bf16x8_t cf[8];
#pragma unroll
                for (int kk = 0; kk < 8; ++kk) cf[kk] = *(const LAS bf16x8_t*)(Ci + c * RSB + (16 * kk + 8 * hi) * 2);
                f32x16 gq;
#pragma unroll
                for (int i = 0; i < 16; ++i) gq[i] = 0.f;
                f32x16 y;
#pragma unroll
                for (int i = 0; i < 16; ++i) y[i] = 0.f;
#pragma unroll
                for (int kk = 0; kk < 8; ++kk) {
                    const bf16x8_t bfr = *(const LAS bf16x8_t*)(Bi + c * RSB + (16 * kk + 8 * hi) * 2); const bf16x8_t hf = *(const LAS bf16x8_t*)(Hc + (32 * pt + c) * RSH + (16 * kk + 8 * hi) * 2);
                    gq = __builtin_amdgcn_mfma_f32_32x32x16_bf16(bfr, cf[kk], gq, 0, 0, 0); y = __builtin_amdgcn_mfma_f32_32x32x16_bf16(cf[kk], hf, y, 0, 0, 0); }
                const float at = AC[c];
                f32x4 as4[4];
#pragma unroll
                for (int rg = 0; rg < 4; ++rg) as4[rg] = *(const LAS f32x4*)(AC + 8 * rg + 4 * hi);
#pragma unroll
                for (int i = 0; i < 16; ++i) { const int s = (i & 3) + 8 * (i >> 2) + 4 * hi; const float e = __builtin_amdgcn_exp2f((at - as4[i >> 2][i & 3]) * LOG2E); gq[i] = (s <= c) ? gq[i] * e : 0.f; }
                bf16x8_t pf[2];
#pragma unroll
                for (int ks = 0; ks < 2; ++ks) { u32x4v wv; wv.x = pk2(gq[8 * ks + 0], gq[8 * ks + 1]); wv.y = pk2(gq[8 * ks + 2], gq[8 * ks + 3]); wv.z = pk2(gq[8 * ks + 4], gq[8 * ks + 5]); wv.w = pk2(gq[8 * ks + 6], gq[8 * ks + 7]); pf[ks] = __builtin_bit_cast(bf16x8_t, wv); }
#pragma unroll
                for (int i = 0; i < 16; ++i) y[i] *= __builtin_amdgcn_exp2f(as4[i >> 2][i & 3] * LOG2E);
#pragma unroll
                for (int ks = 0; ks < 2; ++ks) {
                    const LAS unsigned char* xa = Xi + (16 * ks + 4 * hi + q4) * RSX + (32 * pt + 16 * g1 + 4 * p4) * 2;
                    const bf16x8_t xf = tr_pair(xa, xa + 8 * RSX);
                    y = __builtin_amdgcn_mfma_f32_32x32x16_bf16(pf[ks], xf, y, 0, 0, 0);
                }
                LAS float* OUT = (LAS float*)(lds + SSD_OUT) + (w & 1) * (ST * 64);
#pragma unroll
                for (int i = 0; i < 16; ++i) OUT[((i & 3) + 8 * (i >> 2) + 4 * hi) * 64 + 32 * pt + c] = y[i];
            }
            const float decT = __builtin_amdgcn_exp2f(aT * LOG2E);
#pragma unroll
            for (int i = 0; i < 16; ++i) { hacc0[i] *= decT; hacc1[i] *= decT; }
            bf16x8_t xw[2];
#pragma unroll
            for (int ks = 0; ks < 2; ++ks) {
                const LAS unsigned char* xa = Xi + (16 * ks + 8 * hi + q4) * RSX + (32 * pt + 16 * g1 + 4 * p4) * 2;
                const bf16x8_t xr = tr_pair(xa, xa + 4 * RSX);
                const f32x4 a0 = *(const LAS f32x4*)(AC + 16 * ks + 8 * hi), a1 = *(const LAS f32x4*)(AC + 16 * ks + 8 * hi + 4);
                float f[8];
#pragma unroll
                for (int j = 0; j < 8; ++j) { const float xv = __builtin_bit_cast(float, ((unsigned)(unsigned short)xr[j]) << 16); const float aa = j < 4 ? a0[j & 3] : a1[j & 3]; f[j] = xv * __builtin_amdgcn_exp2f((aT - aa) * LOG2E); }
                u32x4v wv; wv.x = pk2(f[0], f[1]); wv.y = pk2(f[2], f[3]); wv.z = pk2(f[4], f[5]); wv.w = pk2(f[6], f[7]); xw[ks] = __builtin_bit_cast(bf16x8_t, wv);
            }
#pragma unroll
            for (int ks = 0; ks < 2; ++ks) {
                const LAS unsigned char* ba = Bi + (16 * ks + 8 * hi + q4) * RSB + (32 * ntb + 16 * g1 + 4 * p4) * 2;
                const bf16x8_t b0 = tr_pair(ba, ba + 4 * RSB), b1 = tr_pair(ba + 64, ba + 64 + 4 * RSB);
                hacc0 = __builtin_amdgcn_mfma_f32_32x32x16_bf16(b0, xw[ks], hacc0, 0, 0, 0);
                hacc1 = __builtin_amdgcn_mfma_f32_32x32x16_bf16(b1, xw[ks], hacc1, 0, 0, 0);
            }
#pragma unroll
            for (int rg = 0; rg < 4; ++rg) {
                u32x2v o0, o1; o0.x = pk2(hacc0[4 * rg], hacc0[4 * rg + 1]); o0.y = pk2(hacc0[4 * rg + 2], hacc0[4 * rg + 3]); o1.x = pk2(hacc1[4 * rg], hacc1[4 * rg + 1]); o1.y = pk2(hacc1[4 * rg + 2], hacc1[4 * rg + 3]);
                *(LAS u32x2v*)(Hn + (32 * pt + c) * RSH + (32 * ntb + 8 * rg + 4 * hi) * 2) = o0;
                *(LAS u32x2v*)(Hn + (32 * pt + c) * RSH + (32 * (ntb + 1) + 8 * rg + 4 * hi) * 2) = o1;
            }
        }
        __builtin_amdgcn_s_setprio(0);
        if (w > 0) ssd_post<DRY>(w - 1, tid, b, h, lds, ZQ, SSDSS, Dh, Z);
        if (w + 1 < NWIN) ssd_stage_compute(w + 1, tid, lds, R, dtb, aneg);
        ssd_stage_load(w + 3 < NWIN ? w + 3 : NWIN - 1, tid, b, h, g, XBC, XBA, DT, R);
        ssd_loadz(w + 1 < NWIN ? w + 1 : NWIN - 1, tid, b, h, ZQ, Z);
        asm volatile("s_waitcnt lgkmcnt(0)" ::: "memory"); __builtin_amdgcn_s_barrier(); asm volatile("" ::: "memory");
}
template <bool DRY> __device__ __forceinline__ void ssd_item(LAS unsigned char* lds, int item, const bf16_t* XBC, const bf16_t* XBA, const float* DT, bf16_t* ZQ, float* SSDSS, const float* conv_w, const float* conv_b, const float* dt_bias, const float* a_log, const float* d_skip) {
    int tid_l = threadIdx.x; asm volatile("" : "+v"(tid_l));
    const int tid = tid_l, lane = tid & 63, wid = __builtin_amdgcn_readfirstlane(tid >> 6);
    const int b = item >> 4, h = item & 15, g = h >> 2;
    LAS float* CW = (LAS float*)(lds + SSD_CW);
    for (int i = tid; i < 1600; i += 512) { const int k = i / 320, c = i % 320; const int ch = c < 64 ? h * 64 + c : (c < 192 ? 1024 + 128 * g + (c - 64) : 1536 + 128 * g + (c - 192));
        CW[i] = k < 4 ? conv_w[k * CONVD + ch] : conv_b[ch]; }
    { unsigned zz = 0u; asm volatile("" : "+v"(zz));
      for (int i = tid; i < 64 * RSH / 16; i += 512) ((LAS u32x4v*)(lds + SSD_H))[i] = (u32x4v){zz, zz, zz, zz}; }
    const float dtb = dt_bias[h], aneg = -__expf(a_log[h]), Dh = d_skip[h];
    __syncthreads();
    StageRegs RA, RB; ZRegs ZA, ZB;
    ssd_stage_load(0, tid, b, h, g, XBC, XBA, DT, RA); ssd_stage_compute(0, tid, lds, RA, dtb, aneg);
    ssd_stage_load(1, tid, b, h, g, XBC, XBA, DT, RA); ssd_stage_load(2, tid, b, h, g, XBC, XBA, DT, RB); ssd_loadz(0, tid, b, h, ZQ, ZB);
    __syncthreads();
    f32x16 hacc0, hacc1;
#pragma unroll
    for (int i = 0; i < 16; ++i) { hacc0[i] = 0.f; hacc1[i] = 0.f; }
    for (int w = 0; w < NWIN; w += 2) {
        ssd_window<DRY>(w, tid, lane, wid, b, h, g, lds, XBC, XBA, DT, ZQ, SSDSS, dtb, aneg, Dh, hacc0, hacc1, RA, ZA);
        ssd_window<DRY>(w + 1, tid, lane, wid, b, h, g, lds, XBC, XBA, DT, ZQ, SSDSS, dtb, aneg, Dh, hacc0, hacc1, RB, ZB);
    }
    ssd_post<DRY>(NWIN - 1, tid, b, h, lds, ZQ, SSDSS, Dh, ZA);
    __syncthreads();
}

constexpr int ATT_EXL_OFF = 256 * 64 * 4, ATT_K_OFF = ATT_EXL_OFF + 1024, V_RS = 144, V_WAVE_BYTES = 32 * V_RS, ATT_V_OFF = ATT_K_OFF + 8 * V_WAVE_BYTES;
static_assert(ATT_V_OFF + 8 * V_WAVE_BYTES <= PTAB_OFF, "attention LDS");
__device__ __forceinline__ int ex_idx(int row, int ch) { return row * 64 + 4 * (ch ^ (row & 15)); }
__device__ __forceinline__ void attn_tile_desc(int br, int t, int wid, int J, int& kp0, int& kbase, bool& mask) {
    if (br == 0) { kp0 = 256 * J + 32 * wid - 128 + 32 * t; kbase = 32 * t; mask = (t == 0) || (t == 4); }
    else if (br == 1) { kp0 = 4 * (64 * J + 32 * (wid >> 2) - 128 + 32 * t) + (wid & 3); kbase = 32 * t; mask = (t == 0) || (t == 3); }
    else { kp0 = 16 * (32 * (t >> 1)) + 2 * wid + (t & 1); kbase = 32 * (t >> 1); mask = true; }
}
__device__ __forceinline__ void attn_load_V(const bf16_t* Vh, int kp0, int kstride, int vrow_l, int vch, u32x4v (&Vn)[4]) {
#pragma unroll
    for (int i = 0; i < 4; ++i) Vn[i] = *(const u32x4v*)(Vh + (size_t)(kp0 + kstride * (8 * i + vrow_l)) * 64 + 8 * vch);
}
#define CFENCE() asm volatile("" ::: "memory")
template <bool DRY> __device__ __forceinline__ void attn_unit(LAS unsigned char* lds, int b, int h, int J, bf16_t* ZQ, const bf16_t* Kb, const bf16_t* Vb, const float* SSDSS, float nbound, int tid_in) {
    int tid = tid_in; asm volatile("" : "+v"(tid));
    const int lane = tid & 63, wid = __builtin_amdgcn_readfirstlane(tid >> 6), c = lane & 31, hi = lane >> 5;
    LAS float* EX = (LAS float*)lds; LAS float* EXL = (LAS float*)(lds + ATT_EXL_OFF);
    LAS unsigned char* VL = lds + ATT_V_OFF + wid * V_WAVE_BYTES; LAS unsigned char* KL = lds + ATT_K_OFF + wid * V_WAVE_BYTES;
    const LAS unsigned char* kfr = KL + c * V_RS + 16 * hi;
    const size_t rowbase = (size_t)b * SEQ; const int P0 = 256 * J;
    const bf16_t* Kh = Kb + ((size_t)(b * 16 + h) * SEQ) * 64; const bf16_t* Vh = Vb + ((size_t)(b * 16 + h) * SEQ) * 64;
    const int vrow_l = lane >> 3, vch = lane & 7;
    LAS unsigned char* vtr = VL + (4 * hi + ((lane & 15) >> 2)) * V_RS + 32 * ((lane >> 4) & 1) + 8 * (lane & 3);
    if (!DRY) {
        u32x4v yv[4]; f32x4 sv[4];
#pragma unroll
        for (int i = 0; i < 4; ++i) { const size_t row = rowbase + P0 + (tid >> 3) + 64 * i; yv[i] = *(const u32x4v*)(ZQ + row * 2048 + h * 64 + 8 * (tid & 7)); sv[i] = *(const f32x4*)(SSDSS + row * 16 + 4 * (h >> 2)); }
#pragma unroll
        for (int i = 0; i < 4; ++i) { const size_t row = rowbase + P0 + (tid >> 3) + 64 * i; const float rr = __builtin_amdgcn_rsqf(((sv[i][0] + sv[i][1]) + (sv[i][2] + sv[i][3])) * (1.0f / 256.0f) + 1e-6f);
            const f32x4 lo = bf4_to_f32((u32x2v){yv[i].x, yv[i].y}) * rr, hi4 = bf4_to_f32((u32x2v){yv[i].z, yv[i].w}) * rr;
            u32x4v o; o.x = pk2(lo[0], lo[1]); o.y = pk2(lo[2], lo[3]); o.z = pk2(hi4[0], hi4[1]); o.w = pk2(hi4[2], hi4[3]); *(u32x4v*)(ZQ + row * 2048 + h * 64 + 8 * (tid & 7)) = o; }
    }
    for (int br = 0; br < 3; ++br) {
        int qpos, kstride, ntile, t0;
        if (br == 0) { qpos = P0 + 32 * wid + c; kstride = 1; ntile = 5; t0 = 4 - 8 * J - wid; }
        else if (br == 1) { qpos = 4 * (64 * J + 32 * (wid >> 2) + c) + (wid & 3); kstride = 4; ntile = 4; t0 = 4 - 2 * J - (wid >> 2); }
        else { qpos = 16 * (16 * J + (c & 15)) + 2 * wid + (c >> 4); kstride = 16; ntile = J >= 2 ? 2 * (((16 * J - 18) >> 5) + 1) : 0; t0 = 0; }
        if (t0 < 0) t0 = 0;
        const float w16 = br == 0 ? nbound + 1.5849625007f : (br == 1 ? nbound + 1.0f : nbound), w4 = br == 2 ? nbound : nbound + 1.0f;
        const int dlo = br == 0 ? 0 : 33; const unsigned dspan = br == 0 ? 128u : 95u;
        f32x16 o0, o1;
#pragma unroll
        for (int i = 0; i < 16; ++i) { o0[i] = 0.f; o1[i] = 0.f; }
        float lp = 0.f;
        if (t0 < ntile) {
        bf16x8_t qf[4];
        { const bf16_t* qp = ZQ + (rowbase + qpos) * 2048 + 1024 + h * 64 + 8 * hi;
#pragma unroll
          for (int d0 = 0; d0 < 4; ++d0) qf[d0] = *(const bf16x8_t*)(qp + 16 * d0); }
        u32x4v KA[4], KB[4], VA[4], VB[4];
        { int kp0, kbase; bool mk; attn_tile_desc(br, t0, wid, J, kp0, kbase, mk); attn_load_V(Kh, kp0, kstride, vrow_l, vch, KA); CFENCE(); attn_load_V(Vh, kp0, kstride, vrow_l, vch, VA); CFENCE();
          const bool v1 = t0 + 1 < ntile; attn_tile_desc(br, v1 ? t0 + 1 : t0, wid, J, kp0, kbase, mk); const int ks1 = v1 ? kstride : 0;
          attn_load_V(Kh, kp0, ks1, vrow_l, vch, KB); CFENCE(); attn_load_V(Vh, kp0, ks1, vrow_l, vch, VB); CFENCE(); }
#define ATT_STEP(KX, VX, tt) do { const int t = (tt); \
            int kp0, kbase; bool mk; attn_tile_desc(br, t, wid, J, kp0, kbase, mk); \
            const bool vn = t + 2 < ntile; int kpn, kbn; bool mkn; attn_tile_desc(br, vn ? t + 2 : t, wid, J, kpn, kbn, mkn); const int ksn = vn ? kstride : 0; \
            _Pragma("unroll") for (int i = 0; i < 4; ++i) *(LAS u32x4v*)(KL + (8 * i + vrow_l) * V_RS + 16 * vch) = KX[i]; \
            f32x16 s; \
            _Pragma("unroll") for (int i = 0; i < 16; ++i) { const bool q4 = ((c & 3) == (i & 3)); const bool q16 = q4 && (hi == ((c >> 2) & 1)) && (((c >> 3) & 1) == ((i >> 2) & 1)); s[i] = q16 ? w16 : (q4 ? w4 : nbound); }     \
            asm volatile("s_waitcnt lgkmcnt(0)" ::: "memory"); \
            _Pragma("unroll") for (int d0 = 0; d0 < 4; ++d0) { const bf16x8_t kf = *(const LAS bf16x8_t*)(kfr + 32 * d0); s = __builtin_amdgcn_mfma_f32_32x32x16_bf16(kf, qf[d0], s, 0, 0, 0); } \
            CFENCE(); attn_load_V(Kh, kpn, ksn, vrow_l, vch, KX); CFENCE(); \
            if (mk) { \
                int qv = c + 128; \
                if (br == 2) qv = ((c >> 4) == (t & 1)) ? 16 * J + (c & 15) : -(1 << 20); \
                const int dq = qv - kbase - 4 * hi; \
                _Pragma("unroll") for (int i = 0; i < 16; ++i) { const int diff = dq - ((i & 3) + 8 * (i >> 2)); const float e = __builtin_amdgcn_exp2f(s[i]); s[i] = ((unsigned)(diff - dlo) <= dspan) ? e : 0.f; } \
            } else { \
                _Pragma("unroll") for (int i = 0; i < 16; ++i) s[i] = __builtin_amdgcn_exp2f(s[i]); \
            } \
            float ls = 0.f; \
            _Pragma("unroll") for (int i = 0; i < 16; ++i) ls += s[i]; \
            lp += ls; \
            bf16x8_t pf[2]; \
            _Pragma("unroll") for (int ks = 0; ks < 2; ++ks) { u32x4v w; w.x = pk2(s[8 * ks + 0], s[8 * ks + 1]); w.y = pk2(s[8 * ks + 2], s[8 * ks + 3]); w.z = pk2(s[8 * ks + 4], s[8 * ks + 5]); w.w = pk2(s[8 * ks + 6], s[8 * ks + 7]); pf[ks] = __builtin_bit_cast(bf16x8_t, w); } \
            CFENCE(); \
            _Pragma("unroll") for (int i = 0; i < 4; ++i) *(LAS u32x4v*)(VL + (8 * i + vrow_l) * V_RS + 16 * vch) = VX[i]; \
            CFENCE(); attn_load_V(Vh, kpn, ksn, vrow_l, vch, VX); CFENCE(); \
            asm volatile("s_waitcnt lgkmcnt(0)" ::: "memory"); \
            _Pragma("unroll") for (int ks = 0; ks < 2; ++ks) { \
                _Pragma("unroll") for (int dt = 0; dt < 2; ++dt) { \
                    const v4i16_t lo = __builtin_amdgcn_ds_read_tr16_b64_v4i16((LAS v4i16_t*)(vtr + (16 * ks) * V_RS + 64 * dt)); \
                    const v4i16_t hh = __builtin_amdgcn_ds_read_tr16_b64_v4i16((LAS v4i16_t*)(vtr + (16 * ks + 8) * V_RS + 64 * dt)); \
                    const bf16x8_t vf = (bf16x8_t){lo[0], lo[1], lo[2], lo[3], hh[0], hh[1], hh[2], hh[3]}; \
                    if (dt == 0) o0 = __builtin_amdgcn_mfma_f32_32x32x16_bf16(vf, pf[ks], o0, 0, 0, 0); else o1 = __builtin_amdgcn_mfma_f32_32x32x16_bf16(vf, pf[ks], o1, 0, 0, 0); \
                } \
            } \
            asm volatile("s_waitcnt lgkmcnt(0)" ::: "memory"); \
        } while (0)
        for (int tl = t0; ; tl += 2) {
            ATT_STEP(KA, VA, tl);
            if (tl + 1 >= ntile) break;
            ATT_STEP(KB, VB, tl + 1);
            if (tl + 2 >= ntile) break;
        }
#undef ATT_STEP
        }
        lp += __shfl_xor(lp, 32);
        const int ql = qpos - P0;
#pragma unroll
        for (int rg = 0; rg < 4; ++rg) {
            LAS f32x4* e0 = (LAS f32x4*)(EX + ex_idx(ql, 2 * rg + hi)); LAS f32x4* e1 = (LAS f32x4*)(EX + ex_idx(ql, 8 + 2 * rg + hi));
            f32x4 a0 = (f32x4){o0[4 * rg], o0[4 * rg + 1], o0[4 * rg + 2], o0[4 * rg + 3]}, a1 = (f32x4){o1[4 * rg], o1[4 * rg + 1], o1[4 * rg + 2], o1[4 * rg + 3]};
            if (br > 0) { a0 += *e0; a1 += *e1; }
            *e0 = a0; *e1 = a1;
        }
        if (hi == 0) EXL[ql] = (br > 0 ? EXL[ql] : 0.f) + lp;
        asm volatile("s_waitcnt lgkmcnt(0)" ::: "memory"); __builtin_amdgcn_s_barrier(); asm volatile("" ::: "memory");
    }
    int tid2 = tid_in; asm volatile("" : "+v"(tid2));
    const int hrow = tid2 >> 1, hhalf = tid2 & 1;
    f32x4 home[8];
#pragma unroll
    for (int i = 0; i < 8; ++i) home[i] = *(const LAS f32x4*)(EX + ex_idx(hrow, 8 * hhalf + i));
    const float rl = 1.0f / EXL[hrow];
    bf16_t* op = ZQ + (rowbase + P0 + hrow) * 2048 + 1024 + h * 64 + 32 * hhalf;
#pragma unroll
    for (int i = 0; i < 4; ++i) { const f32x4 a = home[2 * i] * rl, bb = home[2 * i + 1] * rl; u32x4v w; w.x = pk2(a[0], a[1]); w.y = pk2(a[2], a[3]); w.z = pk2(bb[0], bb[1]); w.w = pk2(bb[2], bb[3]); if (!DRY || rl == 12345.678f) *(u32x4v*)(op + 8 * i) = w; }
    __syncthreads();
}
__device__ __forceinline__ void attn_phase(LAS unsigned char* lds, bf16_t* ZQ, const bf16_t* Kb, const bf16_t* Vb, const float* SSDSS, const float* qw, const float* kw) {
    int tid_l = threadIdx.x; asm volatile("" : "+v"(tid_l));
    const int lane = tid_l & 63;
    float mq = fabsf(qw[lane]), mk = fabsf(kw[lane]);
#pragma unroll
    for (int o = 1; o < 64; o <<= 1) { mq = fmaxf(mq, __shfl_xor(mq, o)); mk = fmaxf(mk, __shfl_xor(mk, o)); }
    const float nbound = -(64.0f * mq * mk * C2 * 1.01f);
    if (gridDim.x == 256) {
        const int blk = blockIdx.x, xcd = blk & 7, idx = blk >> 3, grp = xcd * 4 + (idx >> 3), k = idx & 7;
        for (int i = 0; i < 8; ++i) { const int bh = grp * 8 + i, J = (k + i) & 7;
#ifdef PROBE_ATT2
            attn_unit<true>(lds, bh >> 4, bh & 15, J, ZQ, Kb, Vb, SSDSS, nbound, tid_l);
#endif
            attn_unit<false>(lds, bh >> 4, bh & 15, J, ZQ, Kb, Vb, SSDSS, nbound, tid_l); }
    } else {
        for (int u = blockIdx.x; u < BATCH * 16 * 8; u += gridDim.x) attn_unit<false>(lds, (u >> 3) >> 4, (u >> 3) & 15, u & 7, ZQ, Kb, Vb, SSDSS, nbound, tid_l);
    }
}

#define XB_TMO      128
#define XB_XCNT(j)  (256  + 64 * (j))
#define XB_XSUB(j)  (1280 + 64 * (j))
#define XB_XGEN(j)  (2304 + 64 * (j))
#define XB_TOP      3328
#define XB_TOPGEN   3392
#define XCD_BAR_WORDS 3456
#define XB_SPIN_CAP (1u << 24)

__device__ __forceinline__ unsigned xb_ld(unsigned* p)              { return __hip_atomic_load(p, __ATOMIC_RELAXED, __HIP_MEMORY_SCOPE_AGENT); }
__device__ __forceinline__ unsigned xb_add(unsigned* p, unsigned v) { return __hip_atomic_fetch_add(p, v, __ATOMIC_RELAXED, __HIP_MEMORY_SCOPE_AGENT); }
__device__ __forceinline__ unsigned xb_xcc_id() { return (unsigned)__builtin_amdgcn_s_getreg((3 << 11) | 20) & 0xFu; }
#define XB_SPIN(cond, bar) do { unsigned _sp = 0; while (cond) { __builtin_amdgcn_s_sleep(1); \
    if ((++_sp & 255u) == 0u) { if (xb_ld(&(bar)[XB_TMO])) break; if (_sp > XB_SPIN_CAP) { atomicAdd(&(bar)[XB_TMO], 1u); break; } } } } while (0)

struct XcdBarrier {
    unsigned* bar; unsigned x;
    volatile LAS unsigned* st;
};

__device__ __forceinline__ XcdBarrier xcd_barrier_post(unsigned* bar, volatile LAS unsigned* st) {
    XcdBarrier b; b.bar = bar; b.x = xb_xcc_id(); b.st = st;
    if (threadIdx.x == 0) (void)xb_add(&bar[XB_XCNT(b.x)], 1u);
    return b;
}
__device__ __forceinline__ void xcd_barrier_complete(unsigned* bar, unsigned x, unsigned& nloc, unsigned& nx) {
    const unsigned G = gridDim.x * gridDim.y * gridDim.z;
    unsigned sum, cnt, mine, sp = 0u;
    for (;;) {
        sum = 0u; cnt = 0u; mine = 0u;
#pragma unroll
        for (unsigned j = 0; j < 16; ++j) { const unsigned c = xb_ld(&bar[XB_XCNT(j)]); sum += c; cnt += (c > 0u) ? 1u : 0u; mine = (j == x) ? c : mine; }
        if (sum == G) break;
        __builtin_amdgcn_s_sleep(1);
        if ((++sp & 255u) == 0u) { if (xb_ld(&bar[XB_TMO])) break; if (sp > XB_SPIN_CAP) { atomicAdd(&bar[XB_TMO], 1u); break; } }
    }
    nloc = mine > 0u ? mine : 1u; nx = cnt > 0u ? cnt : 1u;
}

__device__ __forceinline__ void xcd_barrier(const XcdBarrier& b) {
    asm volatile("s_waitcnt vmcnt(0)" ::: "memory");
    __syncthreads();
    if (threadIdx.x == 0) {
        unsigned* bar = b.bar;
        __builtin_amdgcn_s_waitcnt(0);
        unsigned nloc = b.st[0], nx = b.st[1];
        if (nloc == 0u) { xcd_barrier_complete(bar, b.x, nloc, nx); b.st[0] = nloc; b.st[1] = nx; }
        const unsigned old = xb_add(&bar[XB_XSUB(b.x)], 1u);
        const unsigned gen = old / nloc;
        if (old + 1u == (gen + 1u) * nloc) {
            __builtin_amdgcn_fence(__ATOMIC_RELEASE, "agent");
            asm volatile("s_waitcnt vmcnt(0)" ::: "memory");
            const unsigned og = xb_add(&bar[XB_TOP], 1u);
            const unsigned tg = og / nx;
            if (og + 1u == (tg + 1u) * nx) xb_add(&bar[XB_TOPGEN], 1u);
            else XB_SPIN(xb_ld(&bar[XB_TOPGEN]) == tg, bar);
            __builtin_amdgcn_fence(__ATOMIC_ACQUIRE, "agent");
            xb_add(&bar[XB_XGEN(b.x)], 1u);
            asm volatile("s_waitcnt vmcnt(0)" ::: "memory");
        } else {
            XB_SPIN(xb_ld(&bar[XB_XGEN(b.x)]) == gen, bar);
            __builtin_amdgcn_fence(__ATOMIC_ACQUIRE, "agent");
            asm volatile("s_waitcnt vmcnt(0)" ::: "memory");
        }
    }
    __syncthreads();
}

__device__ __forceinline__ void dt_pass(const bf16_t* XB, const bf16_t* WdtT, const float* SSQ, float* DT) {
    int lane = threadIdx.x & 63; asm volatile("" : "+v"(lane));
    const int wave_s = __builtin_amdgcn_readfirstlane(threadIdx.x >> 6);
    const int r16 = lane & 15, kg = lane >> 4;
    for (int rb = blockIdx.x * 8 + wave_s; rb < M / 16; rb += gridDim.x * 8) {
        const bf16_t* ap = XB + (size_t)(16 * rb + r16) * 1024 + 8 * kg; const bf16_t* bp = WdtT + (size_t)r16 * 1024 + 8 * kg;
        f32x4 acc = (f32x4){0.f, 0.f, 0.f, 0.f};
#pragma unroll 8
        for (int ks = 0; ks < 32; ++ks) { const bf16x8_t a = *(const bf16x8_t*)(ap + 32 * ks), b = *(const bf16x8_t*)(bp + 32 * ks); acc = __builtin_amdgcn_mfma_f32_16x16x32_bf16(a, b, acc, 0, 0, 0); }
#pragma unroll
        for (int rg = 0; rg < 4; ++rg) { const int row = 16 * rb + 4 * kg + rg; DT[(size_t)row * 16 + r16] = acc[rg] * pg8::row_rs(SSQ, row); }
    }
}

__global__ void __launch_bounds__(512, 2) hymba_fwd(Args a) {
    extern __shared__ __attribute__((aligned(16))) unsigned char lds_raw[];
    LAS unsigned char* lds = (LAS unsigned char*)lds_raw;
    cg::grid_group grid = cg::this_grid();
    const int G = gridDim.x;
    unsigned char* ws = a.ws;
    float* X = a.out;
    if (threadIdx.x == 0) {
#pragma unroll
        for (int i = 0; i < 20; ++i) { const unsigned long long p = (unsigned long long)a.in[i]; LAS unsigned* pt = (LAS unsigned*)(lds + PTAB_OFF) + 2 * i; pt[0] = (unsigned)p; pt[1] = (unsigned)(p >> 32); }
    }
    if (threadIdx.x < 2) ((LAS unsigned*)(lds + PTAB_OFF + 512))[threadIdx.x] = 0u;
    const int ph_lo = a.ph_lo, ph_hi = a.ph_hi;
    __syncthreads();
    const XcdBarrier xbar = xcd_barrier_post((unsigned*)(ws + WS_CTL), (volatile LAS unsigned*)(lds + PTAB_OFF + 512));
    bf16_t* XB = (bf16_t*)(ws + WS_XB); bf16_t* HID = (bf16_t*)(ws + WS_HID); bf16_t* ZQ = (bf16_t*)(ws + WS_ZQ); bf16_t* XBC = (bf16_t*)(ws + WS_XBC);
    bf16_t* Kb = (bf16_t*)(ws + WS_K); bf16_t* Vb = (bf16_t*)(ws + WS_V);
    float* SSQ = (float*)(ws + WS_SSQ); float* DT = (float*)(ws + WS_DT); float* SSDSS = (float*)(ws + WS_SSDSS);
    for (int ph = ph_lo; ph < ph_hi; ++ph) {
        if (ph > ph_lo) { if (ph == ph_lo + 1) grid.sync(); else xcd_barrier(xbar); }
#ifdef PROBE_BAR2
        if (ph > ph_lo + 1) { xcd_barrier(xbar); xcd_barrier(xbar); xcd_barrier(xbar); xcd_barrier(xbar); }
#endif
        int tid = threadIdx.x; asm volatile("" : "+v"(tid));
        const int lane = tid & 63, wid = tid >> 6;
        if (ph == 0) {
#ifdef PROBE_CONV2
            for (int rep = 0; rep < 2; ++rep)
#endif
            for (int w = 0; w < 6; ++w) convert_weight(ws, w, 0, lds);
            const int gw = blockIdx.x * 8 + wid, NGW = G * 8;
#ifdef PROBE_CONV2
            for (int rep = 0; rep < 2; ++rep)
#endif
            for (int m = gw; m < M; m += NGW) {
                const f32x4* xr = (const f32x4*)(INP(0) + (size_t)m * DM) + lane; u32x2v* xb = (u32x2v*)(XB + (size_t)m * DM) + lane;
                float s = 0.f;
#pragma unroll
                for (int j = 0; j < 4; ++j) { const f32x4 v = xr[64 * j]; s += (v[0] * v[0] + v[1] * v[1]) + (v[2] * v[2] + v[3] * v[3]); u32x2v w; w.x = pk2(v[0], v[1]); w.y = pk2(v[2], v[3]); xb[64 * j] = w; }
                s = wave_sum(s);
                if (lane < 16) SSQ[(size_t)m * 16 + lane] = lane == 0 ? s : 0.f;
            }
            continue;
        }
        const int L = (ph - 1) >> 3, sub = (ph - 1) & 7;
        { int cv = -1;
          if (L == 0) { cv = sub == 1 ? 0 : sub == 2 ? 1 : sub == 3 ? 2 : sub == 6 ? 3 : sub == 7 ? 4 : -1; } else if (sub == 0) cv = 5;
#ifdef PROBE_CONV2
          if (cv >= 0) { convert_weight(ws, cv, 1, lds); __syncthreads(); }
#endif
          if (cv >= 0) { convert_weight(ws, cv, 1, lds); __syncthreads(); } }
        if (sub == 0 || sub == 6) {
            pg8::Gemm g{XB, (const bf16_t*)(ws + (sub == 0 ? WS_WGU1 : WS_WGU2)), M, NGU, DM}; pg8::StaticOrder S; S.init(M, NGU, G, (int)blockIdx.x);
            pg8::EpiSwiGLU E{HID, SSQ, FF, (LAS float*)(lds + 132096)};
#ifdef PROBE_GEMM2
            pg8::gemm_phase<pg8::EpiSwiGLU, pg8::StaticOrder, true, true>(lds, g, S, E); __syncthreads();
#endif
            pg8::gemm_phase<pg8::EpiSwiGLU, pg8::StaticOrder, true, true>(lds, g, S, E);
        } else if (sub == 1 || sub == 7 || sub == 5) {
            pg8::Gemm g{sub == 5 ? ZQ : HID, (const bf16_t*)(ws + (sub == 1 ? WS_WD1 : sub == 7 ? WS_WD2 : WS_WOUT)), M, DM, sub == 5 ? MIXW : FF}; pg8::StaticOrder S; S.init(M, DM, G, (int)blockIdx.x);
            pg8::EpiResid E{XB, (L == 1 && sub == 7) ? X : (float*)nullptr, SSQ, sub == 5 ? 1.0f : 0.5f};
#ifdef PROBE_GEMM2
            { pg8::EpiResid E0{XB, (float*)nullptr, SSQ, 0.0f}; pg8::gemm_phase<pg8::EpiResid, pg8::StaticOrder, true, true>(lds, g, S, E0); __syncthreads(); }
#endif
            pg8::gemm_phase<pg8::EpiResid, pg8::StaticOrder, true, true>(lds, g, S, E);
        } else if (sub == 2) {
            pg8::Gemm g{XB, (const bf16_t*)(ws + WS_WIN), M, 6144, DM}; pg8::StaticOrder S; S.init(M, 6144, G, (int)blockIdx.x);
            pg8::EpiWin E{ZQ, XBC, Kb, Vb, DT, SSQ, INP(13) + L * 64, INP(14) + L * 64, C2, (LAS float*)(lds + 132096)};
#ifdef PROBE_GEMM2
            pg8::gemm_phase<pg8::EpiWin, pg8::StaticOrder, true, true>(lds, g, S, E); __syncthreads();
#endif
            pg8::gemm_phase<pg8::EpiWin, pg8::StaticOrder, true, true>(lds, g, S, E);
            dt_pass(XB, (const bf16_t*)(ws + WS_WIN) + (size_t)6144 * DM, SSQ, DT);
        } else if (sub == 3) {
#ifdef PROBE_SSD2
            for (int item = blockIdx.x; item < BATCH * 16; item += G)
                ssd_item<true>(lds, item, XBC, (bf16_t*)X, DT, ZQ, SSDSS, INP(7) + (size_t)L * 4 * CONVD, INP(8) + (size_t)L * CONVD, INP(9) + L * 16, INP(10) + L * 16, INP(11) + L * 16);
#endif
            for (int item = blockIdx.x; item < BATCH * 16; item += G) ssd_prepass(item, XBC, (bf16_t*)X, INP(7) + (size_t)L * 4 * CONVD, INP(8) + (size_t)L * CONVD);
            xcd_barrier(xbar);
            for (int item = blockIdx.x; item < BATCH * 16; item += G)
                ssd_item<false>(lds, item, XBC, (bf16_t*)X, DT, ZQ, SSDSS, INP(7) + (size_t)L * 4 * CONVD, INP(8) + (size_t)L * CONVD, INP(9) + L * 16, INP(10) + L * 16, INP(11) + L * 16);
        } else {
            __syncthreads();
            attn_phase(lds, ZQ, Kb, Vb, SSDSS, INP(13) + L * 64, INP(14) + L * 64);
        }
    }
}

extern "C" void kernel_launch(void* const* d_in, const int* in_sizes, int n_in, void* d_out, int out_size, void* d_ws, size_t ws_size, hipStream_t stream) {
    static int grid = 0;
    if (grid == 0) {
        if (n_in != 20 || in_sizes[0] != M * DM || out_size != M * DM || ws_size < WS_CTL + CTL_BYTES) { fprintf(stderr, "kernel_launch: unexpected shapes (n_in %d, ws %zu, need %zu)\n", n_in, ws_size, (size_t)WS_END); grid = -1; return; }
        int dev = 0, cus = 0, per_cu = 0;
        hipGetDevice(&dev); hipDeviceGetAttribute(&cus, hipDeviceAttributeMultiprocessorCount, dev);
        if (hipFuncSetAttribute((const void*)hymba_fwd, hipFuncAttributeMaxDynamicSharedMemorySize, LDS_BYTES) != hipSuccess) fprintf(stderr, "kernel_launch: hipFuncSetAttribute failed\n");
        if (hipOccupancyMaxActiveBlocksPerMultiprocessor(&per_cu, (const void*)hymba_fwd, 512, LDS_BYTES) != hipSuccess || per_cu < 1) { fprintf(stderr, "kernel_launch: occupancy query gave %d\n", per_cu); per_cu = 1; }
        (void)hipGetLastError();
        grid = cus * per_cu;
    }
    if (grid < 0) return;
    if (hipMemsetAsync((char*)d_ws + WS_CTL, 0, CTL_BYTES, stream) != hipSuccess) { fprintf(stderr, "kernel_launch: memset failed\n"); return; }
    Args a{};
    for (int i = 0; i < 20; ++i) a.in[i] = (const float*)d_in[i];
    a.out = (float*)d_out; a.ws = (unsigned char*)d_ws; a.ph_lo = 0; a.ph_hi = NPH;
    void* args[] = {&a};
    hipError_t e = hipLaunchCooperativeKernel((const void*)hymba_fwd, dim3(grid), dim3(512), args, LDS_BYTES, stream);
    if (e != hipSuccess) fprintf(stderr, "cooperative launch failed: %s (grid %d)\n", hipGetErrorString(e), grid);
}
```
